# Optimizing an MI355X kernel written in HIP

```python
import math
import jax, jax.numpy as jnp
from jax import lax
import numpy as np

D_MODEL = 2048
BATCH = 16
SEQ = 256
DEPTH = 4
DEC_BATCH = 2
DEC_SEQ = 2048
PAST_LEN = 512

GRID_W = 64
N_MIXERS = 2
N_RG_LAYERS = (DEPTH + 1) // 2
N_ATTN_LAYERS = DEPTH // 2
N_HEADS = 16
N_KV_HEADS = 4
HEAD_DIM = D_MODEL // N_HEADS
ROT_PAIRS = HEAD_DIM // 4
ROPE_THETA = 10000.0
Q_BLOCK = 128
RNN_WIDTH = D_MODEL
RG_BLOCKS = 16
RG_BLOCK_SIZE = RNN_WIDTH // RG_BLOCKS
RG_C = 8.0
CONV_W = 4
CONV_LEFT = 1
D_FF = 4 * D_MODEL
EPS = 1e-6

kernel_name = "hybrid_rglru_gqa_diffusion_step"


def rmsnorm(x, g):
    xf = x.astype(jnp.float32)
    y = xf * lax.rsqrt(jnp.mean(xf * xf, axis=-1, keepdims=True) + EPS)
    return (y * g.astype(jnp.float32)).astype(x.dtype)


def modulation(cvec, w_mod_l, b_mod_l):
    m = jax.nn.silu(cvec) @ w_mod_l + b_mod_l
    return [t[:, None, :] for t in jnp.split(m, 6, axis=-1)]


def depthwise_conv(x, w, b):
    T = x.shape[1]
    xp = jnp.pad(x, ((0, 0), (CONV_LEFT, CONV_W - 1 - CONV_LEFT), (0, 0)))
    y = b + xp[:, 0:T] * w[0]
    for k in range(1, CONV_W):
        y = y + xp[:, k:k + T] * w[k]
    return y


def rglru_mixer(h, h0, w_in, conv_w, conv_b, w_a, b_a, w_x, b_x, lam, w_out):
    B, T, _ = h.shape
    proj = h @ w_in
    gate_branch, xb = jnp.split(proj, 2, axis=-1)
    xb = depthwise_conv(xb, conv_w, conv_b)
    xblk = xb.reshape(B, T, RG_BLOCKS, RG_BLOCK_SIZE)
    r = jax.nn.sigmoid(jnp.einsum('btnj,enjk->betnk', xblk, w_a).reshape(B, 2, T, RNN_WIDTH)
                       + b_a[None, :, None, :]).astype(jnp.float32)
    i = jax.nn.sigmoid(jnp.einsum('btnj,enjk->betnk', xblk, w_x).reshape(B, 2, T, RNN_WIDTH)
                       + b_x[None, :, None, :]).astype(jnp.float32)
    log_a = -RG_C * jax.nn.softplus(-lam.astype(jnp.float32))[None, :, None, :] * r
    a = jnp.exp(log_a)
    u = jnp.sqrt(-jnp.expm1(2.0 * log_a)) * i * xb.astype(jnp.float32)[:, None]
    a = jnp.stack([a[:, 0], jnp.flip(a[:, 1], axis=1)], axis=1)
    u = jnp.stack([u[:, 0], jnp.flip(u[:, 1], axis=1)], axis=1)
    a_t = jnp.moveaxis(a, 2, 0)
    u_t = jnp.moveaxis(u, 2, 0)

    def step(hc, inp):
        at, ut = inp
        hn = at * hc + ut
        return hn, hn

    h_final, hs = lax.scan(step, h0.astype(jnp.float32), (a_t, u_t))
    y = hs[:, :, 0] + jnp.flip(hs[:, :, 1], axis=0)
    y = jnp.moveaxis(y, 0, 1).astype(h.dtype)
    out = (y * jax.nn.gelu(gate_branch)) @ w_out
    return out, h_final.astype(h.dtype)


def qkv_heads(h, w_qkv, g_q, g_k):
    B, T, _ = h.shape
    qkv = h @ w_qkv
    q = qkv[..., :N_HEADS * HEAD_DIM].reshape(B, T, N_HEADS, HEAD_DIM)
    k = qkv[..., N_HEADS * HEAD_DIM:(N_HEADS + N_KV_HEADS) * HEAD_DIM].reshape(B, T, N_KV_HEADS, HEAD_DIM)
    v = qkv[..., (N_HEADS + N_KV_HEADS) * HEAD_DIM:].reshape(B, T, N_KV_HEADS, HEAD_DIM)
    return rmsnorm(q, g_q), rmsnorm(k, g_k), v


def grid_rope_tables(n_tokens):
    rows = n_tokens // GRID_W
    row = jnp.broadcast_to(jnp.arange(rows, dtype=jnp.float32)[:, None], (rows, GRID_W)).reshape(-1)
    col = jnp.broadcast_to(jnp.arange(GRID_W, dtype=jnp.float32)[None, :], (rows, GRID_W)).reshape(-1)
    inv_freq = ROPE_THETA ** (-jnp.arange(ROT_PAIRS, dtype=jnp.float32) / ROT_PAIRS)
    ang_r = (row[:, None] * inv_freq[None, :])[:, None, :]
    ang_c = (col[:, None] * inv_freq[None, :])[:, None, :]
    return jnp.cos(ang_r), jnp.sin(ang_r), jnp.cos(ang_c), jnp.sin(ang_c)


def apply_rope2d(x, tables):
    cos_r, sin_r, cos_c, sin_c = tables
    xf = x.astype(jnp.float32)
    xr, xc = jnp.split(xf, 2, axis=-1)

    def rot(z, cos, sin):
        z1, z2 = jnp.split(z, 2, axis=-1)
        return jnp.concatenate([z1 * cos - z2 * sin, z2 * cos + z1 * sin], axis=-1)

    return jnp.concatenate([rot(xr, cos_r, sin_r), rot(xc, cos_c, sin_c)], axis=-1).astype(x.dtype)


def blocked_attention(q, k, v):
    B, S, H, hd = q.shape
    G = H // N_KV_HEADS
    nb = S // Q_BLOCK
    qb = q.reshape(B, nb, Q_BLOCK, N_KV_HEADS, G, hd).transpose(1, 0, 2, 3, 4, 5)
    scale = 1.0 / math.sqrt(hd)

    def one_block(qblk):
        s = jnp.einsum('bqkgd,btkd->bkgqt', qblk, k).astype(jnp.float32) * scale
        p = jax.nn.softmax(s, axis=-1).astype(v.dtype)
        return jnp.einsum('bkgqt,btkd->bqkgd', p, v)

    o = lax.map(one_block, qb)
    return o.transpose(1, 0, 2, 3, 4, 5).reshape(B, S, H * hd)


def squared_relu_mlp(x, w1, w2):
    hdn = jax.nn.relu(x @ w1)
    return (hdn * hdn) @ w2


def setup_inputs(seed: int = 0) -> dict:
    key = jax.random.key(seed)
    ks = iter(jax.random.split(key, 40))

    def nrm(shape, scale):
        return jax.random.normal(next(ks), shape, jnp.float32) * scale

    def gain(shape):
        return 1.0 + nrm(shape, 0.02)

    D = D_MODEL
    qkv_w = (N_HEADS + 2 * N_KV_HEADS) * HEAD_DIM
    a0 = jax.random.uniform(next(ks), (N_RG_LAYERS, 2, RNN_WIDTH), jnp.float32, 0.9, 0.999)
    p = a0 ** (1.0 / RG_C)
    rg_lambda = jnp.log(p) - jnp.log1p(-p)
    return {
        "x_prompt": nrm((BATCH, SEQ, D), 1.0),
        "x_sample": nrm((DEC_BATCH, DEC_SEQ, D), 1.0),
        "state_rglru": nrm((DEC_BATCH, N_RG_LAYERS, 2, RNN_WIDTH), 0.5),
        "cache_k": nrm((DEC_BATCH, N_ATTN_LAYERS, PAST_LEN, N_KV_HEADS, HEAD_DIM), 1.0),
        "cache_v": nrm((DEC_BATCH, N_ATTN_LAYERS, PAST_LEN, N_KV_HEADS, HEAD_DIM), 1.0),
        "c": nrm((DEC_BATCH, D), 1.0),
        "c_ctx": nrm((D,), 1.0),
        "w_mod": nrm((DEPTH, D, 6 * D), 0.5 * D ** -0.5),
        "b_mod": nrm((DEPTH, 6 * D), 0.01),
        "g_pre_mix": gain((DEPTH, D)),
        "g_post_mix": gain((DEPTH, D)),
        "g_pre_ffn": gain((DEPTH, D)),
        "g_post_ffn": gain((DEPTH, D)),
        "w_qkv": nrm((N_ATTN_LAYERS, D, qkv_w), D ** -0.5),
        "g_q": gain((N_ATTN_LAYERS, HEAD_DIM)),
        "g_k": gain((N_ATTN_LAYERS, HEAD_DIM)),
        "w_o": nrm((N_ATTN_LAYERS, N_HEADS * HEAD_DIM, D), (N_HEADS * HEAD_DIM) ** -0.5),
        "w_rg_in": nrm((N_RG_LAYERS, D, 2 * RNN_WIDTH), D ** -0.5),
        "rg_conv_w": nrm((N_RG_LAYERS, CONV_W, RNN_WIDTH), CONV_W ** -0.5),
        "rg_conv_b": nrm((N_RG_LAYERS, RNN_WIDTH), 0.01),
        "w_rg_a": nrm((N_RG_LAYERS, 2, RG_BLOCKS, RG_BLOCK_SIZE, RG_BLOCK_SIZE), RG_BLOCK_SIZE ** -0.5),
        "b_rg_a": nrm((N_RG_LAYERS, 2, RNN_WIDTH), 0.01),
        "w_rg_x": nrm((N_RG_LAYERS, 2, RG_BLOCKS, RG_BLOCK_SIZE, RG_BLOCK_SIZE), RG_BLOCK_SIZE ** -0.5),
        "b_rg_x": nrm((N_RG_LAYERS, 2, RNN_WIDTH), 0.01),
        "rg_lambda": rg_lambda,
        "w_rg_out": nrm((N_RG_LAYERS, RNN_WIDTH, D), RNN_WIDTH ** -0.5),
        "w_ff1": nrm((DEPTH, D, D_FF), D ** -0.5),
        "w_ff2": nrm((DEPTH, D_FF, D), D_FF ** -0.5),
    }


def reference(x_prompt, x_sample, state_rglru, cache_k, cache_v, c, c_ctx,
              w_mod, b_mod, g_pre_mix, g_post_mix, g_pre_ffn, g_post_ffn,
              w_qkv, g_q, g_k, w_o,
              w_rg_in, rg_conv_w, rg_conv_b, w_rg_a, b_rg_a, w_rg_x, b_rg_x, rg_lambda, w_rg_out,
              w_ff1, w_ff2):
    xp = x_prompt
    xs = x_sample
    rope_tab = grid_rope_tables(xs.shape[1])
    new_states, new_ks, new_vs = [], [], []

    for l in range(DEPTH):
        mp = modulation(c_ctx[None, :], w_mod[l], b_mod[l])
        ms = modulation(c, w_mod[l], b_mod[l])
        hp = rmsnorm(xp, g_pre_mix[l]) * (1.0 + mp[1]) + mp[0]
        hs = rmsnorm(xs, g_pre_mix[l]) * (1.0 + ms[1]) + ms[0]
        j = l // N_MIXERS
        if l % N_MIXERS == 0:
            rg = (w_rg_in[j], rg_conv_w[j], rg_conv_b[j], w_rg_a[j], b_rg_a[j],
                  w_rg_x[j], b_rg_x[j], rg_lambda[j], w_rg_out[j])
            h0 = jnp.zeros((xp.shape[0], 2, RNN_WIDTH), xp.dtype)
            op, st = rglru_mixer(hp, h0, *rg)
            os_, _ = rglru_mixer(hs, state_rglru[:, j], *rg)
            new_states.append(st)
        else:
            qp, kp, vp = qkv_heads(hp, w_qkv[j], g_q[j], g_k[j])
            op = blocked_attention(qp, kp, vp) @ w_o[j]
            new_ks.append(kp)
            new_vs.append(vp)
            qs, ks_, vs_ = qkv_heads(hs, w_qkv[j], g_q[j], g_k[j])
            qs = apply_rope2d(qs, rope_tab)
            ks_ = apply_rope2d(ks_, rope_tab)
            k_all = jnp.concatenate([ks_, cache_k[:, j]], axis=1)
            v_all = jnp.concatenate([vs_, cache_v[:, j]], axis=1)
            os_ = blocked_attention(qs, k_all, v_all) @ w_o[j]
        xp = xp + mp[2] * rmsnorm(op, g_post_mix[l])
        xs = xs + ms[2] * rmsnorm(os_, g_post_mix[l])
        fp = rmsnorm(xp, g_pre_ffn[l]) * (1.0 + mp[4]) + mp[3]
        fs = rmsnorm(xs, g_pre_ffn[l]) * (1.0 + ms[4]) + ms[3]
        xp = xp + mp[5] * rmsnorm(squared_relu_mlp(fp, w_ff1[l], w_ff2[l]), g_post_ffn[l])
        xs = xs + ms[5] * rmsnorm(squared_relu_mlp(fs, w_ff1[l], w_ff2[l]), g_post_ffn[l])

    new_state_rglru = jnp.stack(new_states, axis=1)
    new_cache_k = jnp.stack(new_ks, axis=1)
    new_cache_v = jnp.stack(new_vs, axis=1)
    return (xp, xs, new_state_rglru, new_cache_k, new_cache_v)
```

```cpp
#include <hip/hip_runtime.h>
#include <hip/hip_bf16.h>
#include <cstdio>
#include <cstdint>

#ifndef MK_ONE_LAUNCH
#define MK_ONE_LAUNCH 0
#endif
#ifndef MK_NAIVE_RG
#define MK_NAIVE_RG 1
#endif
#ifndef MK_NAIVE_ATTN
#define MK_NAIVE_ATTN 1
#endif
namespace pg8 {
#define PG8_LAS __attribute__((address_space(3)))
typedef unsigned short bf16_t;
typedef short bf16x8 __attribute__((ext_vector_type(8)));
typedef float f32x4 __attribute__((ext_vector_type(4)));
typedef unsigned u32x4 __attribute__((ext_vector_type(4)));
constexpr int BM = 256, BK = 64, HALF = 128, HTB = HALF * BK * 2  , STAGE_BYTES = 8 * HTB, NXCD = 8, WGM = 8;

__host__ __device__ __forceinline__ int lds_byte(int r, int c) { const int st = (r >> 4) * 2 + (c >> 5), rr = r & 15, cc = c & 31, ob = rr * 64 + cc * 2; return st * 1024 + (ob ^ (((ob >> 9) & 1) << 5)); }
__host__ __device__ __forceinline__ void stage_rc(int b, int& R, int& C) { const int st = b / 1024, sb = b % 1024, swz = sb ^ (((sb >> 9) & 1) << 5); R = (st >> 1) * 16 + swz / 64; C = (st & 1) * 32 + (swz % 64) / 2; }
__host__ __device__ __forceinline__ int perm32(int rho) { const int n = rho >> 4, i = rho & 15; return 8 * (i >> 2) + 4 * n + (i & 3); }

struct Unit { int pm, pn; };
struct Gemm { const bf16_t* A; const bf16_t* Bt; int M, N, K; };

struct StaticOrder {
    int nM, nN, nwg, G, c;
    __host__ __device__ void init(int M, int N, int G_, int c_) { nM = M / BM; nN = N / BM; nwg = nM * nN; G = G_; c = c_; }
    __host__ __device__ bool next(int i, Unit& u) const {
        const long L = (long)i * G + c; if (L >= nwg) return false;
        int wgid = (int)L; { const int q = nwg / NXCD, r = nwg % NXCD, xcd = wgid % NXCD, off = wgid / NXCD; wgid = (xcd < r ? xcd * (q + 1) : r * (q + 1) + (xcd - r) * q) + off; }
        const int nig = WGM * nN, gid = wgid / nig, fm = gid * WGM, gsz = (nM - fm) < WGM ? (nM - fm) : WGM;
        u.pm = fm + ((wgid % nig) % gsz); u.pn = (wgid % nig) / gsz; return true;
    }
    __device__ __forceinline__ void a_ready(const Unit&) const {}
    __device__ __forceinline__ void done(const Unit&) const {}
};

__device__ __forceinline__ unsigned cvt_pk_bf16(float lo, float hi) { unsigned r; asm volatile("v_cvt_pk_bf16_f32 %0, %1, %2" : "=v"(r) : "v"(lo), "v"(hi)); return r; }
typedef float f32x2 __attribute__((ext_vector_type(2)));
struct EpiF32 {
    static constexpr bool PERM = false, AFTER_DRAIN = false;
    float* C; int ldc;
    __device__ __forceinline__ void operator()(const f32x4 (&acc)[2][2][4][2], const Unit& u, int wr, int wc, int fr, int fq) const {
        const int row0 = u.pm * BM + wr * 64 + fr, col0 = u.pn * BM + wc * 32 + 4 * fq;
#pragma unroll
        for (int ai = 0; ai < 2; ++ai)
#pragma unroll
            for (int m = 0; m < 4; ++m) { float* rowp = C + (size_t)(row0 + ai * HALF + m * 16) * ldc + col0;
#pragma unroll
                for (int bj = 0; bj < 2; ++bj)
#pragma unroll
                    for (int n = 0; n < 2; ++n) *(f32x4*)(rowp + bj * HALF + n * 16) = acc[ai][bj][m][n]; }
    }
};
struct EpiRelu2 {
    static constexpr bool PERM = true, AFTER_DRAIN = false;
    bf16_t* O; int ldc;
    __device__ __forceinline__ void operator()(const f32x4 (&acc)[2][2][4][2], const Unit& u, int wr, int wc, int fr, int fq) const {
        const int row0 = u.pm * BM + wr * 64 + fr, col0 = u.pn * BM + wc * 32 + 8 * fq;
#pragma unroll
        for (int ai = 0; ai < 2; ++ai)
#pragma unroll
            for (int m = 0; m < 4; ++m) { bf16_t* rowp = O + (size_t)(row0 + ai * HALF + m * 16) * ldc + col0;
#pragma unroll
                for (int bj = 0; bj < 2; ++bj) { f32x4 v0 = acc[ai][bj][m][0], v1 = acc[ai][bj][m][1];
                    v0 = __builtin_elementwise_max(v0, (f32x4){0.f, 0.f, 0.f, 0.f}); v1 = __builtin_elementwise_max(v1, (f32x4){0.f, 0.f, 0.f, 0.f}); v0 = v0 * v0; v1 = v1 * v1;
                    u32x4 w; w.x = cvt_pk_bf16(v0[0], v0[1]); w.y = cvt_pk_bf16(v0[2], v0[3]); w.z = cvt_pk_bf16(v1[0], v1[1]); w.w = cvt_pk_bf16(v1[2], v1[3]);
                    *(u32x4*)(rowp + bj * HALF) = w; } }
    }
};
__device__ __forceinline__ float gelu_tanh_f(float v) {
    const float u = v * (0.7978845608028654f + 0.035677408136300125f * v * v);
    const float t = __builtin_amdgcn_exp2f(-2.885390081777927f * u);
    return v * __builtin_amdgcn_rcpf(1.0f + t);
}
struct EpiRgIn {
    static constexpr bool PERM = true, AFTER_DRAIN = false;
    bf16_t* G; float* XB;
    __device__ __forceinline__ void operator()(const f32x4 (&acc)[2][2][4][2], const Unit& u, int wr, int wc, int fr, int fq) const {
        const int row0 = u.pm * BM + wr * 64 + fr;
        if (u.pn < 8) {
            const int col0 = u.pn * BM + wc * 32 + 8 * fq;
#pragma unroll
            for (int ai = 0; ai < 2; ++ai)
#pragma unroll
                for (int m = 0; m < 4; ++m) { bf16_t* rowp = G + (size_t)(row0 + ai * HALF + m * 16) * 2048 + col0;
#pragma unroll
                    for (int bj = 0; bj < 2; ++bj) { const f32x4 v0 = acc[ai][bj][m][0], v1 = acc[ai][bj][m][1];
                        u32x4 w; w.x = cvt_pk_bf16(gelu_tanh_f(v0[0]), gelu_tanh_f(v0[1])); w.y = cvt_pk_bf16(gelu_tanh_f(v0[2]), gelu_tanh_f(v0[3]));
                        w.z = cvt_pk_bf16(gelu_tanh_f(v1[0]), gelu_tanh_f(v1[1])); w.w = cvt_pk_bf16(gelu_tanh_f(v1[2]), gelu_tanh_f(v1[3]));
                        *(u32x4*)(rowp + bj * HALF) = w; } }
        } else {
            const int col0 = (u.pn - 8) * BM + wc * 32 + 8 * fq;
#pragma unroll
            for (int ai = 0; ai < 2; ++ai)
#pragma unroll
                for (int m = 0; m < 4; ++m) { float* rowp = XB + (size_t)(row0 + ai * HALF + m * 16) * 2048 + col0;
#pragma unroll
                    for (int bj = 0; bj < 2; ++bj) { *(f32x4*)(rowp + bj * HALF) = acc[ai][bj][m][0]; *(f32x4*)(rowp + bj * HALF + 4) = acc[ai][bj][m][1]; } }
        }
    }
};
template <class Epi, class Sched, bool ALIGN_EPI = false, bool SP2 = false>
__device__ __forceinline__ void gemm_phase(PG8_LAS unsigned char* lds, const Gemm g, const Sched& S, const Epi& E) {
    int tid_l = threadIdx.x; asm volatile("" : "+v"(tid_l)); const int tid = tid_l, wid = __builtin_amdgcn_readfirstlane(tid >> 6), lane = tid & 63, wr = wid >> 2, wc = wid & 3, fr = lane & 15, fq = lane >> 4;
    const int K = g.K, nt = K / BK;
    unsigned voffA[2], voffB[2];
#pragma unroll
    for (int i = 0; i < 2; ++i) { int R, C; stage_rc(tid * 16 + i * 8192, R, C); const int Rb = Epi::PERM ? ((R & ~31) + perm32(R & 31)) : R;
        voffA[i] = (unsigned)(R * K + C) * 2u; voffB[i] = (unsigned)(Rb * K + C) * 2u; }
    const size_t kstep = (size_t)(BK * 2);
    const size_t hstep = (size_t)HALF * K * 2;
    const size_t tstep = 2 * hstep;
    const unsigned ldsw = (unsigned)wid * 1024u;
    const int aoff = lds_byte(wr * 64 + fr, fq * 8), boff = lds_byte(wc * 32 + fr, fq * 8);
#define PG8_SA(b, h) (((b) * 2 + (h)) * HTB)
#define PG8_SB(b, h) ((4 + (b) * 2 + (h)) * HTB)
#define PG8_STAGE(bufoff, gbase, voff) do { _Pragma("unroll") for (int _i = 0; _i < 2; ++_i) \
        __builtin_amdgcn_global_load_lds((const unsigned*)((const char*)(gbase) + (voff)[_i]), (PG8_LAS unsigned*)(lds + (bufoff) + ldsw + _i * 8192), 16, 0, 0); } while (0)
#define PG8_LDA(dst, b, h) do { _Pragma("unroll") for (int m = 0; m < 4; ++m) _Pragma("unroll") for (int k = 0; k < 2; ++k) dst[m][k] = *(const PG8_LAS bf16x8*)(lds + PG8_SA(b, h) + aoff + m * 2048 + k * 1024); } while (0)
#define PG8_LDB(dst, b, h) do { _Pragma("unroll") for (int n = 0; n < 2; ++n) _Pragma("unroll") for (int k = 0; k < 2; ++k) dst[n][k] = *(const PG8_LAS bf16x8*)(lds + PG8_SB(b, h) + boff + n * 2048 + k * 1024); } while (0)
#define PG8_MMA(ai, bj, At, Bt) do { __builtin_amdgcn_s_setprio(1); _Pragma("unroll") for (int m = 0; m < 4; ++m) _Pragma("unroll") for (int n = 0; n < 2; ++n) _Pragma("unroll") for (int k = 0; k < 2; ++k) \
        acc[ai][bj][m][n] = __builtin_amdgcn_mfma_f32_16x16x32_bf16(Bt[n][k], At[m][k], acc[ai][bj][m][n], 0, 0, 0); __builtin_amdgcn_s_setprio(0); } while (0)
#define PG8_WAIT_V(n) asm volatile("s_waitcnt vmcnt(" #n ")" ::: "memory")
#define PG8_WAIT_L(n) asm volatile("s_waitcnt lgkmcnt(" #n ")" ::: "memory")
#define PG8_BAR __builtin_amdgcn_s_barrier()
#define PG8_SCHED __builtin_amdgcn_sched_barrier(0)
    Unit cur, nxt; int ui = 0;
    if (!S.next(0, cur)) return;
    f32x4 acc[2][2][4][2];
#pragma unroll
    for (int a = 0; a < 2; ++a)
#pragma unroll
        for (int b = 0; b < 2; ++b)
#pragma unroll
            for (int m = 0; m < 4; ++m)
#pragma unroll
                for (int n = 0; n < 2; ++n) acc[a][b][m][n] = (f32x4){0.f, 0.f, 0.f, 0.f};
    bf16x8 At[4][2], B0[2][2], B1[2][2];
    const char* cA = (const char*)g.A + (size_t)cur.pm * tstep; const char* cB = (const char*)g.Bt + (size_t)cur.pn * tstep;
    S.a_ready(cur);
    if constexpr (SP2) {
        PG8_STAGE(PG8_SB(0, 0), cB, voffB); PG8_STAGE(PG8_SB(0, 1), cB + hstep, voffB); PG8_STAGE(PG8_SA(0, 0), cA, voffA); PG8_STAGE(PG8_SA(0, 1), cA + hstep, voffA);
        if (wr == 1) PG8_BAR;
        PG8_WAIT_V(2); PG8_BAR;
        PG8_STAGE(PG8_SB(1, 0), cB + kstep, voffB); PG8_STAGE(PG8_SA(1, 0), cA + kstep, voffA); PG8_STAGE(PG8_SB(1, 1), cB + hstep + kstep, voffB);
        PG8_WAIT_V(6); PG8_BAR;
    } else {
        PG8_STAGE(PG8_SB(0, 0), cB, voffB); PG8_STAGE(PG8_SA(0, 0), cA, voffA); PG8_STAGE(PG8_SB(0, 1), cB + hstep, voffB); PG8_STAGE(PG8_SA(0, 1), cA + hstep, voffA);
        if (wr == 1) PG8_BAR;
        PG8_WAIT_V(4); PG8_BAR;
        PG8_STAGE(PG8_SB(1, 0), cB + kstep, voffB); PG8_STAGE(PG8_SA(1, 0), cA + kstep, voffA); PG8_STAGE(PG8_SB(1, 1), cB + hstep + kstep, voffB);
        PG8_WAIT_V(6); PG8_BAR;
    }
    for (;;) {
        const bool has_next = S.next(ui + 1, nxt);
        const char* nA = has_next ? (const char*)g.A + (size_t)nxt.pm * tstep : cA; const char* nB = has_next ? (const char*)g.Bt + (size_t)nxt.pn * tstep : cB;
        for (int t = 0; t < nt; t += 2) {
            const bool last = (t == nt - 2);
            const char* a1 = cA + (size_t)(t + 1) * kstep;
            const char* a2 = last ? nA : cA + (size_t)(t + 2) * kstep; const char* b2 = last ? nB : cB + (size_t)(t + 2) * kstep;
            const char* a3 = a2 + kstep; const char* b3 = b2 + kstep;
            if (last && has_next) S.a_ready(nxt);
            if constexpr (SP2) {
            PG8_LDB(B0, 0, 0); PG8_LDB(B1, 0, 1); PG8_SCHED; PG8_LDA(At, 0, 0); PG8_STAGE(PG8_SA(1, 1), a1 + hstep, voffA);
            PG8_WAIT_V(8); PG8_WAIT_L(0); PG8_BAR; PG8_MMA(0, 0, At, B0); PG8_MMA(0, 1, At, B1); PG8_BAR; PG8_SCHED;
            PG8_LDA(At, 0, 1); PG8_STAGE(PG8_SB(0, 0), b2, voffB); PG8_STAGE(PG8_SB(0, 1), b2 + hstep, voffB); PG8_STAGE(PG8_SA(0, 0), a2, voffA);
            PG8_WAIT_V(8); PG8_WAIT_L(0); PG8_BAR; PG8_MMA(1, 0, At, B0); PG8_MMA(1, 1, At, B1); PG8_BAR; PG8_SCHED;
            PG8_LDB(B0, 1, 0); PG8_LDB(B1, 1, 1); PG8_SCHED; PG8_LDA(At, 1, 0); PG8_STAGE(PG8_SA(0, 1), a2 + hstep, voffA);
            PG8_WAIT_V(8); PG8_WAIT_L(0); PG8_BAR; PG8_MMA(0, 0, At, B0); PG8_MMA(0, 1, At, B1); PG8_BAR; PG8_SCHED;
            PG8_LDA(At, 1, 1); PG8_STAGE(PG8_SB(1, 0), b3, voffB); PG8_STAGE(PG8_SB(1, 1), b3 + hstep, voffB); PG8_STAGE(PG8_SA(1, 0), a3, voffA);
            PG8_WAIT_V(8); PG8_WAIT_L(0); PG8_BAR; PG8_MMA(1, 0, At, B0); PG8_MMA(1, 1, At, B1); PG8_BAR; PG8_SCHED;
            } else {
            PG8_LDB(B0, 0, 0); PG8_SCHED; PG8_LDA(At, 0, 0); PG8_STAGE(PG8_SA(1, 1), a1 + hstep, voffA);
            PG8_WAIT_L(8); PG8_BAR; PG8_WAIT_L(0); PG8_MMA(0, 0, At, B0); PG8_BAR; PG8_SCHED;
            PG8_LDB(B1, 0, 1); PG8_STAGE(PG8_SB(0, 0), b2, voffB);
            PG8_BAR; PG8_WAIT_L(0); PG8_MMA(0, 1, At, B1); PG8_BAR;
            PG8_LDA(At, 0, 1); PG8_STAGE(PG8_SA(0, 0), a2, voffA);
            PG8_BAR; PG8_WAIT_L(0); PG8_MMA(1, 0, At, B0); PG8_BAR; PG8_SCHED;
            PG8_STAGE(PG8_SB(0, 1), b2 + hstep, voffB);
            PG8_WAIT_V(6); PG8_BAR; PG8_MMA(1, 1, At, B1); PG8_BAR;
            PG8_LDB(B0, 1, 0); PG8_SCHED; PG8_LDA(At, 1, 0); PG8_STAGE(PG8_SA(0, 1), a2 + hstep, voffA);
            PG8_WAIT_L(8); PG8_BAR; PG8_WAIT_L(0); PG8_MMA(0, 0, At, B0); PG8_BAR; PG8_SCHED;
            PG8_LDB(B1, 1, 1); PG8_STAGE(PG8_SB(1, 0), b3, voffB);
            PG8_BAR; PG8_WAIT_L(0); PG8_MMA(0, 1, At, B1); PG8_BAR;
            PG8_LDA(At, 1, 1); PG8_STAGE(PG8_SA(1, 0), a3, voffA);
            PG8_BAR; PG8_WAIT_L(0); PG8_MMA(1, 0, At, B0); PG8_BAR; PG8_SCHED;
            PG8_STAGE(PG8_SB(1, 1), b3 + hstep, voffB);
            PG8_WAIT_V(6); PG8_BAR; PG8_MMA(1, 1, At, B1); PG8_BAR;
            }
        }
        if constexpr (ALIGN_EPI) { if (wr == 0) PG8_BAR; }
        if constexpr (!Epi::AFTER_DRAIN) { E(acc, cur, wr, wc, fr, fq); S.done(cur); }
        if (!has_next) break;
#pragma unroll
        for (int a = 0; a < 2; ++a)
#pragma unroll
            for (int b = 0; b < 2; ++b)
#pragma unroll
                for (int m = 0; m < 4; ++m)
#pragma unroll
                    for (int n = 0; n < 2; ++n) acc[a][b][m][n] = (f32x4){0.f, 0.f, 0.f, 0.f};
        cur = nxt; cA = nA; cB = nB; ++ui;
        if constexpr (ALIGN_EPI) { if (wr == 1) PG8_BAR; }
    }
    PG8_WAIT_V(0);
    if constexpr (!ALIGN_EPI) { if (wr == 0) PG8_BAR; }
    PG8_BAR;
    if constexpr (Epi::AFTER_DRAIN) { E.fused(acc, cur, wr, wc, fr, fq, lds, wid, lane); S.done(cur); }
#undef PG8_SA
#undef PG8_SB
#undef PG8_STAGE
#undef PG8_LDA
#undef PG8_LDB
#undef PG8_MMA
#undef PG8_WAIT_V
#undef PG8_WAIT_L
#undef PG8_BAR
#undef PG8_SCHED
}
}
#define GAS __attribute__((address_space(1)))
#define LAS __attribute__((address_space(3)))
typedef unsigned short bf16;
typedef unsigned v4u __attribute__((ext_vector_type(4)));
typedef float f32x4 __attribute__((ext_vector_type(4)));
typedef short bf16x8 __attribute__((ext_vector_type(8)));
typedef GAS unsigned gu32;
typedef GAS unsigned long long gu64;
#define RLX_AGENT __ATOMIC_RELAXED, __HIP_MEMORY_SCOPE_AGENT
#define LDS_WAIT() asm volatile("s_waitcnt lgkmcnt(0)" ::: "memory")
#define VM_WAIT() asm volatile("s_waitcnt vmcnt(0)" ::: "memory")
__device__ __forceinline__ unsigned long long rt() { return __builtin_amdgcn_s_memrealtime(); }
__device__ __forceinline__ unsigned f2bf(float f) { unsigned u = __builtin_bit_cast(unsigned, f); return (u + 0x7fffu + ((u >> 16) & 1u)) >> 16; }
__device__ __forceinline__ unsigned pk2(float lo, float hi) { return f2bf(lo) | (f2bf(hi) << 16); }
#define XB_TMO      128
#define XB_XCNT(j)  (256  + 64 * (j))
#define XB_XSUB(j)  (1280 + 64 * (j))
#define XB_XGEN(j)  (2304 + 64 * (j))
#define XB_TOP      3328
#define XB_TOPGEN   3392
#define XCD_BAR_WORDS 3456
#define XB_SPIN_CAP (1u << 18)

__device__ __forceinline__ unsigned xb_ld(unsigned* p)              { return __hip_atomic_load(p, __ATOMIC_RELAXED, __HIP_MEMORY_SCOPE_AGENT); }
__device__ __forceinline__ unsigned xb_add(unsigned* p, unsigned v) { return __hip_atomic_fetch_add(p, v, __ATOMIC_RELAXED, __HIP_MEMORY_SCOPE_AGENT); }
__device__ __forceinline__ unsigned xb_xcc_id() { return (unsigned)__builtin_amdgcn_s_getreg((3 << 11) | 20) & 0xFu; }
#define XB_SPIN(cond, bar) do { unsigned _sp = 0; while (cond) { __builtin_amdgcn_s_sleep(1); \
    if ((++_sp & 255u) == 0u) { if (xb_ld(&(bar)[XB_TMO])) break; if (_sp > XB_SPIN_CAP) { atomicAdd(&(bar)[XB_TMO], 1u); break; } } } } while (0)

struct XcdBarrier {
    unsigned* bar; unsigned x;
    volatile LAS unsigned* st;
};

__device__ __forceinline__ XcdBarrier xcd_barrier_post(unsigned* bar, volatile LAS unsigned* st) {
    XcdBarrier b; b.bar = bar; b.x = xb_xcc_id(); b.st = st;
    if (threadIdx.x == 0) (void)xb_add(&bar[XB_XCNT(b.x)], 1u);
    return b;
}
__device__ __forceinline__ void xcd_barrier_complete(unsigned* bar, unsigned x, unsigned& nloc, unsigned& nx) {
    const unsigned G = gridDim.x * gridDim.y * gridDim.z;
    unsigned sum, cnt, mine, sp = 0u;
    for (;;) {
        sum = 0u; cnt = 0u; mine = 0u;
#pragma unroll
        for (unsigned j = 0; j < 16; ++j) { const unsigned c = xb_ld(&bar[XB_XCNT(j)]); sum += c; cnt += (c > 0u) ? 1u : 0u; mine = (j == x) ? c : mine; }
        if (sum == G) break;
        __builtin_amdgcn_s_sleep(1);
        if ((++sp & 255u) == 0u) { if (xb_ld(&bar[XB_TMO])) break; if (sp > XB_SPIN_CAP) { atomicAdd(&bar[XB_TMO], 1u); break; } }
    }
    nloc = mine > 0u ? mine : 1u; nx = cnt > 0u ? cnt : 1u;
}

__device__ __forceinline__ void xcd_barrier(const XcdBarrier& b) {
    asm volatile("s_waitcnt vmcnt(0)" ::: "memory");
    __syncthreads();
    if (threadIdx.x == 0) {
        unsigned* bar = b.bar;
        __builtin_amdgcn_s_waitcnt(0);
        unsigned nloc = b.st[0], nx = b.st[1];
        if (nloc == 0u) { xcd_barrier_complete(bar, b.x, nloc, nx); b.st[0] = nloc; b.st[1] = nx; }
        const unsigned old = xb_add(&bar[XB_XSUB(b.x)], 1u);
        const unsigned gen = old / nloc;
        if (old + 1u == (gen + 1u) * nloc) {
            __builtin_amdgcn_fence(__ATOMIC_RELEASE, "agent");
            asm volatile("s_waitcnt vmcnt(0)" ::: "memory");
            const unsigned og = xb_add(&bar[XB_TOP], 1u);
            const unsigned tg = og / nx;
            if (og + 1u == (tg + 1u) * nx) xb_add(&bar[XB_TOPGEN], 1u);
            else XB_SPIN(xb_ld(&bar[XB_TOPGEN]) == tg, bar);
            __builtin_amdgcn_fence(__ATOMIC_ACQUIRE, "agent");
            xb_add(&bar[XB_XGEN(b.x)], 1u);
            asm volatile("s_waitcnt vmcnt(0)" ::: "memory");
        } else {
            XB_SPIN(xb_ld(&bar[XB_XGEN(b.x)]) == gen, bar);
            __builtin_amdgcn_fence(__ATOMIC_ACQUIRE, "agent");
            asm volatile("s_waitcnt vmcnt(0)" ::: "memory");
        }
    }
    __syncthreads();
}

constexpr int D = 2048, M = 8192, MP = 4096, FF = 8192, NQKV = 3072, RGW = 4096;
constexpr int NL = 4;
constexpr float EPS = 1e-6f;
constexpr int NWAVES = 8, NTHR = 512;
constexpr int OUT_ST = 2 * MP * D;
constexpr int OUT_CK = OUT_ST + 16 * 2 * 2 * 2048;
constexpr int OUT_CV = OUT_CK + 16 * 2 * 256 * 512;
constexpr int OUT_TOTAL = OUT_CV + 16 * 2 * 256 * 512;
enum { I_XP = 0, I_XS, I_STATE, I_CK, I_CV, I_C, I_CCTX, I_WMOD, I_BMOD, I_GPREMIX, I_GPOSTMIX, I_GPREFFN, I_GPOSTFFN, I_WQKV, I_GQ, I_GK, I_WO,
       I_WRGIN, I_CONVW, I_CONVB, I_WRGA, I_BRGA, I_WRGX, I_BRGX, I_LAM, I_WRGOUT, I_WFF1, I_WFF2, N_IN };

constexpr size_t MiB = 1u << 20;
constexpr size_t WS_CTL = 0, CTL_ZERO_BYTES = 1 * MiB;
constexpr size_t WS_MODP = 2 * MiB;
constexpr size_t WS_MODF = 5 * MiB;
constexpr size_t WS_ROPE = 6 * MiB;
constexpr size_t WS_W1T = 8 * MiB;
constexpr size_t WS_W2T = 136 * MiB;
constexpr size_t WS_WQKVT = 264 * MiB;
constexpr size_t WS_WOT = 288 * MiB;
constexpr size_t WS_WRGINT = 304 * MiB;
constexpr size_t WS_WRGOUTT = 336 * MiB;
constexpr size_t WS_XN = 352 * MiB;
constexpr size_t WS_BR = 384 * MiB;
constexpr size_t WS_H = 448 * MiB;
constexpr size_t WS_QKV = 576 * MiB;
constexpr size_t WS_QB = 672 * MiB;
constexpr size_t WS_MIX = 704 * MiB;
constexpr size_t WS_KP = 736 * MiB, WS_VP = 740 * MiB;
constexpr size_t WS_KS = 744 * MiB, WS_VS = 754 * MiB;
constexpr size_t WS_GATE = 764 * MiB;
constexpr size_t WS_XB = 796 * MiB;
constexpr size_t WS_HF = 860 * MiB;
constexpr size_t WS_END = 892 * MiB;
constexpr size_t WS_NXC = WS_H, WS_NAF = WS_H + 64 * MiB, WS_NUF = WS_QKV, WS_NAB = WS_QKV + 64 * MiB, WS_NUB = WS_BR;

constexpr int LDS_BYTES = 147456;
constexpr int LDSCTL_OFF = LDS_BYTES - 512;

constexpr int NPH = 3 + 10 * NL;
__host__ __device__ inline bool phase_active(int p) {
    if (p < 3) return true;
    const int l = (p - 3) / 10, s = (p - 3) % 10; const bool rg = (l & 1) == 0;
    if (s == 1) return !rg || MK_NAIVE_RG;
    if (s == 3 || s == 4) return rg && MK_NAIVE_RG;
    return true;
}

struct Args { const float* in[N_IN]; float* out; unsigned char* ws; int ph_lo, ph_hi; };
#define PH_LOCALS unsigned char* const ws = a.ws + zz; float* const out = a.out + zz; (void)ws; (void)out

__device__ __forceinline__ float wave_sum(float v) {
#pragma unroll
    for (int o = 1; o < 64; o <<= 1) v += __shfl_xor(v, o);
    return v;
}
__device__ __forceinline__ int mod_idx(int row) { return row < MP ? 0 : 1 + ((row - MP) >> 11); }
__device__ __forceinline__ unsigned long long pack4(f32x4 v) { return (unsigned long long)pg8::cvt_pk_bf16(v.x, v.y) | ((unsigned long long)pg8::cvt_pk_bf16(v.z, v.w) << 32); }
__device__ __forceinline__ v4u pack8(f32x4 a, f32x4 b) { v4u w; w.x = pg8::cvt_pk_bf16(a.x, a.y); w.y = pg8::cvt_pk_bf16(a.z, a.w); w.z = pg8::cvt_pk_bf16(b.x, b.y); w.w = pg8::cvt_pk_bf16(b.z, b.w); return w; }
__device__ __forceinline__ float bf2f(unsigned short b) { return __builtin_bit_cast(float, (unsigned)b << 16); }
__device__ __forceinline__ float sigmoid_f(float x) { return __builtin_amdgcn_rcpf(1.0f + __builtin_amdgcn_exp2f(-1.4426950408889634f * x)); }

__device__ __forceinline__ void p0_transpose_item(const float* W, int K, int N, bf16* WT, LAS float* scr, int item, int lane) {
    const int nblk = N / 32, kb = item / nblk, nb = item % nblk, k0 = 64 * kb, n0 = 32 * nb;
#pragma unroll 8
    for (int i = 0; i < 32; ++i) { const int kk = 2 * i + (lane >> 5); scr[kk * 33 + (lane & 31)] = W[(size_t)(k0 + kk) * N + n0 + (lane & 31)]; }
    LDS_WAIT(); asm volatile("" ::: "memory");
    const int c = lane & 7;
#pragma unroll
    for (int j = 0; j < 4; ++j) { const int n = (lane >> 3) + 8 * j; const LAS float* s = scr + (8 * c) * 33 + n;
        v4u o; o.x = pk2(s[0 * 33], s[1 * 33]); o.y = pk2(s[2 * 33], s[3 * 33]); o.z = pk2(s[4 * 33], s[5 * 33]); o.w = pk2(s[6 * 33], s[7 * 33]);
        *(GAS v4u*)(WT + (size_t)(n0 + n) * K + k0 + 8 * c) = o; }
    LDS_WAIT(); asm volatile("" ::: "memory");
}
__constant__ float INV_FREQ[32] = {1.f, 0.749894261f, 0.562341332f, 0.421696514f, 0.316227764f, 0.237137377f, 0.177827939f, 0.133352131f, 0.100000001f, 0.0749894157f, 0.0562341325f, 0.0421696529f,
    0.0316227749f, 0.0237137377f, 0.0177827943f, 0.0133352149f, 0.00999999978f, 0.00749894185f, 0.00562341325f, 0.00421696482f, 0.00316227763f, 0.00237137359f, 0.00177827943f, 0.00133352145f,
    0.00100000005f, 0.000749894243f, 0.000562341302f, 0.000421696517f, 0.000316227757f, 0.00023713737f, 0.00017782794f, 0.00013335215f};
__device__ __forceinline__ void sincos_d(double a, double& s, double& c) {
    const double k = __builtin_rint(a * 0.6366197723675814);
    double r = __builtin_fma(-k, 1.5707963267948966, a); r = __builtin_fma(-k, 6.123233995736766e-17, r);
    const double r2 = r * r;
    double sp = -7.647163731819816e-13; sp = sp * r2 + 1.6059043836821613e-10; sp = sp * r2 - 2.505210838544172e-08; sp = sp * r2 + 2.7557319223985893e-06; sp = sp * r2 - 1.984126984126984e-04;
    sp = sp * r2 + 8.333333333333333e-03; sp = sp * r2 - 1.6666666666666666e-01; sp = r + r * r2 * sp;
    double cp = 4.779477332387385e-14; cp = cp * r2 - 1.1470745597729725e-11; cp = cp * r2 + 2.08767569878681e-09; cp = cp * r2 - 2.755731922398589e-07; cp = cp * r2 + 2.48015873015873e-05;
    cp = cp * r2 - 1.388888888888889e-03; cp = cp * r2 + 4.1666666666666664e-02; cp = cp * r2 - 0.5; cp = 1.0 + r2 * cp;
    const int q = (int)k & 3;
    s = (q == 0) ? sp : (q == 1) ? cp : (q == 2) ? -sp : -cp;
    c = (q == 0) ? cp : (q == 1) ? -sp : (q == 2) ? -cp : sp;
}
__device__ __forceinline__ void ph_prologue(const Args& a, int zz, LAS unsigned char* lds, int tid, int lane, int wave, int G) {
    PH_LOCALS;
    {
        LAS float* scr = (LAS float*)(lds + wave * 16384);
        const int gw = blockIdx.x * NWAVES + wave, NGW = G * NWAVES;
        for (int it = gw; it < 88064; it += NGW) {
            const float* W; bf16* WT; int K, N, r;
            if (it < 32768)      { r = it;         const int l = r >> 13; r &= 8191; W = a.in[zz + I_WFF1] + (size_t)l * 2048 * 8192; K = 2048; N = 8192; WT = (bf16*)(ws + WS_W1T) + (size_t)l * 8192 * 2048; }
            else if (it < 65536) { r = it - 32768; const int l = r >> 13; r &= 8191; W = a.in[zz + I_WFF2] + (size_t)l * 8192 * 2048; K = 8192; N = 2048; WT = (bf16*)(ws + WS_W2T) + (size_t)l * 2048 * 8192; }
            else if (it < 71680) { r = it - 65536; const int j = r / 3072; r -= j * 3072; W = a.in[zz + I_WQKV] + (size_t)j * 2048 * 3072; K = 2048; N = 3072; WT = (bf16*)(ws + WS_WQKVT) + (size_t)j * 3072 * 2048; }
            else if (it < 75776) { r = it - 71680; const int j = r >> 11; r &= 2047; W = a.in[zz + I_WO] + (size_t)j * 2048 * 2048; K = 2048; N = 2048; WT = (bf16*)(ws + WS_WOT) + (size_t)j * 2048 * 2048; }
            else if (it < 83968) { r = it - 75776; const int j = r >> 12; r &= 4095; W = a.in[zz + I_WRGIN] + (size_t)j * 2048 * 4096; K = 2048; N = 4096; WT = (bf16*)(ws + WS_WRGINT) + (size_t)j * 4096 * 2048; }
            else                 { r = it - 83968; const int j = r >> 11; r &= 2047; W = a.in[zz + I_WRGOUT] + (size_t)j * 2048 * 2048; K = 2048; N = 2048; WT = (bf16*)(ws + WS_WRGOUTT) + (size_t)j * 2048 * 2048; }
            p0_transpose_item(W, K, N, WT, scr, r, lane);
        }
    }
    __syncthreads();
    {
        LAS float* S = (LAS float*)lds;
        LAS float* red = (LAS float*)(lds + 24576);
        for (int i = tid; i < 3 * 2048; i += NTHR) { const int ci = i >> 11, k = i & 2047; const float x = ci == 0 ? a.in[zz + I_CCTX][k] : a.in[zz + I_C][(ci - 1) * 2048 + k]; S[i] = x * sigmoid_f(x); }
        __syncthreads();
        float* MODP = (float*)(ws + WS_MODP);
        for (int bi = blockIdx.x; bi < 768; bi += G) {
            const int l = bi / 192, rem = bi % 192, cc = rem >> 2, kg = rem & 3, k0 = kg * 512 + wave * 64;
            const float* wp = a.in[zz + I_WMOD] + ((size_t)l * 2048 + k0) * 12288 + cc * 256 + lane * 4;
            f32x4 a0 = {0.f, 0.f, 0.f, 0.f}, a1 = a0, a2 = a0;
#pragma unroll 8
            for (int kk = 0; kk < 64; ++kk) { const f32x4 w = __builtin_nontemporal_load((const f32x4*)(wp + (size_t)kk * 12288));
                const float s0 = S[k0 + kk], s1 = S[2048 + k0 + kk], s2 = S[4096 + k0 + kk]; a0 += w * s0; a1 += w * s1; a2 += w * s2; }
            *(LAS f32x4*)(red + (wave * 3 + 0) * 256 + lane * 4) = a0; *(LAS f32x4*)(red + (wave * 3 + 1) * 256 + lane * 4) = a1; *(LAS f32x4*)(red + (wave * 3 + 2) * 256 + lane * 4) = a2;
            __syncthreads();
            for (int e = tid; e < 768; e += NTHR) { const int i = e >> 8, col = e & 255; float s = 0.f;
#pragma unroll
                for (int w = 0; w < 8; ++w) s += red[(w * 3 + i) * 256 + col];
                MODP[((size_t)(kg * 4 + l) * 3 + i) * 12288 + cc * 256 + col] = s; }
            __syncthreads();
        }
    }
    {
        const int gtid = blockIdx.x * NTHR + tid, NGT = G * NTHR;
        for (int t = gtid; t < 2 * 131072; t += NGT) {
            const int kv = t >> 17, e = (t & 131071) * 8;
            const int b = e >> 19, j = (e >> 18) & 1, p = (e >> 9) & 511, c = e & 511;
            const float* src = (kv ? a.in[zz + I_CV] : a.in[zz + I_CK]) + e;
            const f32x4 v0 = *(const f32x4*)src, v1 = *(const f32x4*)(src + 4);
            bf16* dst = (bf16*)(ws + (kv ? WS_VS : WS_KS)) + ((size_t)(j * 2 + b) * 2560 + 2048 + p) * 512 + c;
            *(v4u*)dst = pack8(v0, v1);
        }
        if (gtid < 2048) { const int pos = gtid >> 5, p = gtid & 31; const float ang = (float)pos * INV_FREQ[p]; double s, c; sincos_d((double)ang, s, c);
            float* R = (float*)(ws + WS_ROPE); R[gtid] = (float)c; R[2048 + gtid] = (float)s; }
    }
}
__device__ __forceinline__ void ph_modreduce(const Args& a, int zz, int tid, int G) {
    PH_LOCALS;
    const float* MODP = (const float*)(ws + WS_MODP); float* MODF = (float*)(ws + WS_MODF);
    const int gtid = blockIdx.x * NTHR + tid, NGT = G * NTHR;
    for (int e = gtid; e < 4 * 3 * 12288; e += NGT) {
        const int n = e % 12288, li = e / 12288, l = li / 3, q = n >> 11, c = n & 2047;
        float m = a.in[zz + I_BMOD][l * 12288 + n];
#pragma unroll
        for (int kg = 0; kg < 4; ++kg) m += MODP[((size_t)(kg * 4 + l) * 3 + (li - l * 3)) * 12288 + n];
        float v = m;
        if (q == 1) v = a.in[zz + I_GPREMIX][l * 2048 + c] * (1.f + m);
        else if (q == 2) v = a.in[zz + I_GPOSTMIX][l * 2048 + c] * m;
        else if (q == 4) v = a.in[zz + I_GPREFFN][l * 2048 + c] * (1.f + m);
        else if (q == 5) v = a.in[zz + I_GPOSTFFN][l * 2048 + c] * m;
        MODF[(size_t)li * 12288 + n] = v;
    }
}
__device__ __forceinline__ const float* modf_vec(const unsigned char* ws, int l, int idx, int q) { return (const float*)(ws + WS_MODF) + ((size_t)(l * 3 + idx) * 6 + q) * 2048; }
__device__ __forceinline__ void ph_pre0(const Args& a, int zz, int lane, int wave, int G) {
    PH_LOCALS;
    const int gw = blockIdx.x * NWAVES + wave, NGW = G * NWAVES;
    bf16* XN = (bf16*)(ws + WS_XN);
    for (int task = gw; task < M / 4; task += NGW) {
        const int row0 = task * 4, idx = mod_idx(row0);
        const f32x4* Sv = (const f32x4*)modf_vec(ws, 0, idx, 1) + lane; const f32x4* Bv = (const f32x4*)modf_vec(ws, 0, idx, 0) + lane;
        f32x4 S[8], B[8];
#pragma unroll
        for (int j = 0; j < 8; ++j) { S[j] = Sv[64 * j]; B[j] = Bv[64 * j]; }
#pragma unroll 1
        for (int r = 0; r < 4; ++r) {
            const int row = row0 + r;
            const f32x4* xr = (const f32x4*)(row < MP ? a.in[zz + I_XP] + (size_t)row * D : a.in[zz + I_XS] + (size_t)(row - MP) * D) + lane;
            f32x4 v[8]; float ss = 0.f;
#pragma unroll
            for (int j = 0; j < 8; ++j) { v[j] = xr[64 * j]; ss += (v[j].x * v[j].x + v[j].y * v[j].y) + (v[j].z * v[j].z + v[j].w * v[j].w); }
            const float rs = rsqrtf(wave_sum(ss) * (1.f / D) + EPS);
            unsigned long long* o8 = (unsigned long long*)(XN + (size_t)row * D) + lane;
#pragma unroll
            for (int j = 0; j < 8; ++j) o8[64 * j] = pack4(v[j] * rs * S[j] + B[j]);
        }
    }
}
__device__ __forceinline__ void ph_post(const Args& a, int zz, int l, int which, int lane, int wave, int G) {
    PH_LOCALS;
    const int gw = blockIdx.x * NWAVES + wave, NGW = G * NWAVES;
    const bool has_next = (which == 0) || (l < NL - 1);
    const int ln = which == 0 ? l : l + 1, qG = which == 0 ? 2 : 5, qS = which == 0 ? 4 : 1, qB = which == 0 ? 3 : 0;
    const bool first = (l == 0 && which == 0);
    const float* BR = (const float*)(ws + WS_BR); bf16* XN = (bf16*)(ws + WS_XN);
    for (int task = gw; task < M / 4; task += NGW) {
        const int row0 = task * 4, idx = mod_idx(row0);
        f32x4 Gv[8], S[8], B[8];
        { const f32x4* p = (const f32x4*)modf_vec(ws, l, idx, qG) + lane;
#pragma unroll
          for (int j = 0; j < 8; ++j) Gv[j] = p[64 * j]; }
        if (has_next) { const f32x4* ps = (const f32x4*)modf_vec(ws, ln, idx, qS) + lane; const f32x4* pb = (const f32x4*)modf_vec(ws, ln, idx, qB) + lane;
#pragma unroll
          for (int j = 0; j < 8; ++j) { S[j] = ps[64 * j]; B[j] = pb[64 * j]; } }
        else {
#pragma unroll
          for (int j = 0; j < 8; ++j) { S[j] = (f32x4){0.f, 0.f, 0.f, 0.f}; B[j] = S[j]; } }
#pragma unroll 1
        for (int r = 0; r < 4; ++r) {
            const int row = row0 + r;
            const f32x4* br = (const f32x4*)(BR + (size_t)row * D) + lane;
            const f32x4* xr = (const f32x4*)(first ? (row < MP ? a.in[zz + I_XP] + (size_t)row * D : a.in[zz + I_XS] + (size_t)(row - MP) * D) : out + (size_t)row * D) + lane;
            f32x4 v[8], x[8]; float ss = 0.f;
#pragma unroll
            for (int j = 0; j < 8; ++j) { v[j] = br[64 * j]; x[j] = xr[64 * j]; ss += (v[j].x * v[j].x + v[j].y * v[j].y) + (v[j].z * v[j].z + v[j].w * v[j].w); }
            const float rs = rsqrtf(wave_sum(ss) * (1.f / D) + EPS);
            f32x4* xo = (f32x4*)(out + (size_t)row * D) + lane; float s2 = 0.f;
#pragma unroll
            for (int j = 0; j < 8; ++j) { x[j] = x[j] + Gv[j] * (v[j] * rs); xo[64 * j] = x[j]; s2 += (x[j].x * x[j].x + x[j].y * x[j].y) + (x[j].z * x[j].z + x[j].w * x[j].w); }
            if (has_next) {
                const float rs2 = rsqrtf(wave_sum(s2) * (1.f / D) + EPS);
                unsigned long long* o8 = (unsigned long long*)(XN + (size_t)row * D) + lane;
#pragma unroll
                for (int j = 0; j < 8; ++j) o8[64 * j] = pack4(x[j] * rs2 * S[j] + B[j]);
            }
        }
    }
}
__device__ __forceinline__ void ph_qknorm(const Args& a, int zz, int j, int lane, int wave, int G) {
    PH_LOCALS;
    const int gw = blockIdx.x * NWAVES + wave, NGW = G * NWAVES;
    const int hq = lane >> 4, q16 = lane & 15;
    const float* QKV = (const float*)(ws + WS_QKV); const float* ROPE = (const float*)(ws + WS_ROPE);
    bf16* QB = (bf16*)(ws + WS_QB); bf16* KP = (bf16*)(ws + WS_KP); bf16* VP = (bf16*)(ws + WS_VP);
    bf16* KSj = (bf16*)(ws + WS_KS) + (size_t)j * 2 * 2560 * 512; bf16* VSj = (bf16*)(ws + WS_VS) + (size_t)j * 2 * 2560 * 512;
    const f32x4 gq0 = *(const f32x4*)(a.in[zz + I_GQ] + j * 128 + q16 * 8), gq1 = *(const f32x4*)(a.in[zz + I_GQ] + j * 128 + q16 * 8 + 4);
    const f32x4 gk0 = *(const f32x4*)(a.in[zz + I_GK] + j * 128 + q16 * 8), gk1 = *(const f32x4*)(a.in[zz + I_GK] + j * 128 + q16 * 8 + 4);
    const float sgn = (q16 & 4) ? 1.f : -1.f;
    for (int row = gw; row < M; row += NGW) {
        const bool samp = row >= MP; const int b = samp ? (row - MP) >> 11 : row >> 8, t = samp ? (row - MP) & 2047 : row & 255;
        f32x4 c0 = {1.f, 1.f, 1.f, 1.f}, c1 = c0, s0 = {0.f, 0.f, 0.f, 0.f}, s1 = s0;
        if (samp) { const int pos = (q16 < 8) ? (t >> 6) : (t & 63); const float* rp = ROPE + pos * 32 + 8 * (q16 & 3);
            c0 = *(const f32x4*)rp; c1 = *(const f32x4*)(rp + 4); s0 = *(const f32x4*)(rp + 2048); s1 = *(const f32x4*)(rp + 2052); }
#pragma unroll
        for (int it = 0; it < 6; ++it) {
            const float* src = QKV + (size_t)row * NQKV + it * 512 + hq * 128 + q16 * 8;
            f32x4 v0 = *(const f32x4*)src, v1 = *(const f32x4*)(src + 4);
            if (it < 5) {
                float ss = (v0.x * v0.x + v0.y * v0.y) + (v0.z * v0.z + v0.w * v0.w) + (v1.x * v1.x + v1.y * v1.y) + (v1.z * v1.z + v1.w * v1.w);
                ss += __shfl_xor(ss, 1); ss += __shfl_xor(ss, 2); ss += __shfl_xor(ss, 4); ss += __shfl_xor(ss, 8);
                const float rs = rsqrtf(ss * (1.f / 128.f) + EPS);
                v0 = v0 * rs * (it < 4 ? gq0 : gk0); v1 = v1 * rs * (it < 4 ? gq1 : gk1);
                if (samp) {
                    f32x4 p0, p1;
                    p0.x = __shfl_xor(v0.x, 4); p0.y = __shfl_xor(v0.y, 4); p0.z = __shfl_xor(v0.z, 4); p0.w = __shfl_xor(v0.w, 4);
                    p1.x = __shfl_xor(v1.x, 4); p1.y = __shfl_xor(v1.y, 4); p1.z = __shfl_xor(v1.z, 4); p1.w = __shfl_xor(v1.w, 4);
                    v0 = v0 * c0 + (p0 * s0) * sgn; v1 = v1 * c1 + (p1 * s1) * sgn;
                }
            }
            const v4u pk = pack8(v0, v1);
            if (it < 4) *(v4u*)(QB + (size_t)row * D + it * 512 + hq * 128 + q16 * 8) = pk;
            else {
                bf16* dstS = (it == 4 ? KSj : VSj) + ((size_t)b * 2560 + t) * 512 + hq * 128 + q16 * 8;
                bf16* dstP = (it == 4 ? KP : VP) + (size_t)row * 512 + hq * 128 + q16 * 8;
                if (samp) *(v4u*)dstS = pk;
                else { *(v4u*)dstP = pk; float* o = out + (it == 4 ? OUT_CK : OUT_CV) + ((size_t)(b * 2 + j) * 256 + t) * 512 + hq * 128 + q16 * 8; *(f32x4*)o = v0; *(f32x4*)(o + 4) = v1; }
            }
        }
    }
}

__device__ __forceinline__ float rg_coef(float lam) {
    const float x = __expf(-lam);
    const float l1p = (x < 0.05f) ? x * (1.f + x * (-0.5f + x * (0.33333333f + x * (-0.25f + x * (0.2f + x * (-0.16666667f)))))) : __logf(1.f + x);
    return -8.0f * l1p;
}
__device__ __forceinline__ void rg_elem(float racc, float iacc, float coef, float xc, float& a, float& u) {
    const float r = sigmoid_f(racc), ig = sigmoid_f(iacc), la = coef * r;
    a = __builtin_amdgcn_exp2f(1.4426950408889634f * la);
    const float z = 2.f * la;
    const float m1 = (z > -0.1f) ? -z * (1.f + z * (0.5f + z * (0.16666667f + z * (0.041666668f + z * 0.0083333338f)))) : 1.f - a * a;
    u = __builtin_amdgcn_sqrtf(m1) * ig * xc;
}
__device__ __forceinline__ void seq_bounds(int row, int& s0, int& T) { if (row < MP) { s0 = row & ~255; T = 256; } else { s0 = MP + ((row - MP) & ~2047); T = 2048; } }

#if MK_NAIVE_RG
__device__ __forceinline__ void ph_rg_conv_naive(const Args& a, int zz, int jl, int tid, int G) {
    PH_LOCALS;
    const int gtid = blockIdx.x * NTHR + tid, NGT = G * NTHR;
    const float* XB = (const float*)(ws + WS_XB); float* XC = (float*)(ws + WS_NXC);
    const float* cw = a.in[zz + I_CONVW] + (size_t)jl * 4 * 2048; const float* cb = a.in[zz + I_CONVB] + (size_t)jl * 2048;
    for (int task = gtid; task < M * 512; task += NGT) {
        const int row = task >> 9, c4 = (task & 511) * 4; int s0, T; seq_bounds(row, s0, T);
        f32x4 acc = *(const f32x4*)(cb + c4);
#pragma unroll
        for (int k = 0; k < 4; ++k) { const int r2 = row + k - 1; if (r2 >= s0 && r2 < s0 + T) acc += *(const f32x4*)(cw + k * 2048 + c4) * *(const f32x4*)(XB + (size_t)r2 * 2048 + c4); }
        *(f32x4*)(XC + (size_t)row * 2048 + c4) = acc;
    }
}
__device__ __forceinline__ void ph_rg_gates_naive(const Args& a, int zz, int jl, int tid, int G) {
    PH_LOCALS;
    const int gtid = blockIdx.x * NTHR + tid, NGT = G * NTHR;
    const float* XC = (const float*)(ws + WS_NXC);
    float* AF = (float*)(ws + WS_NAF); float* UF = (float*)(ws + WS_NUF); float* AB = (float*)(ws + WS_NAB); float* UB = (float*)(ws + WS_NUB);
    for (int task = gtid; task < M * 2048; task += NGT) {
        const int row = task >> 11, ch = task & 2047, n = ch >> 7, k = ch & 127;
        const float* xc = XC + (size_t)row * 2048 + n * 128;
        const float* wa0 = a.in[zz + I_WRGA] + ((size_t)((jl * 2 + 0) * 16 + n) * 128) * 128 + k; const float* wa1 = a.in[zz + I_WRGA] + ((size_t)((jl * 2 + 1) * 16 + n) * 128) * 128 + k;
        const float* wx0 = a.in[zz + I_WRGX] + ((size_t)((jl * 2 + 0) * 16 + n) * 128) * 128 + k; const float* wx1 = a.in[zz + I_WRGX] + ((size_t)((jl * 2 + 1) * 16 + n) * 128) * 128 + k;
        float r0 = 0.f, r1 = 0.f, i0 = 0.f, i1 = 0.f;
#pragma unroll 8
        for (int j = 0; j < 128; ++j) { const float x = xc[j]; r0 += x * wa0[j * 128]; r1 += x * wa1[j * 128]; i0 += x * wx0[j * 128]; i1 += x * wx1[j * 128]; }
        const float xv = xc[k];
        float av, uv;
        rg_elem(r0 + a.in[zz + I_BRGA][(jl * 2 + 0) * 2048 + ch], i0 + a.in[zz + I_BRGX][(jl * 2 + 0) * 2048 + ch], rg_coef(a.in[zz + I_LAM][(jl * 2 + 0) * 2048 + ch]), xv, av, uv);
        AF[task] = av; UF[task] = uv;
        rg_elem(r1 + a.in[zz + I_BRGA][(jl * 2 + 1) * 2048 + ch], i1 + a.in[zz + I_BRGX][(jl * 2 + 1) * 2048 + ch], rg_coef(a.in[zz + I_LAM][(jl * 2 + 1) * 2048 + ch]), xv, av, uv);
        AB[task] = av; UB[task] = uv;
    }
}
__device__ __forceinline__ void ph_rg_scan_naive(const Args& a, int zz, int jl, int tid, int G) {
    PH_LOCALS;
    const int gtid = blockIdx.x * NTHR + tid, NGT = G * NTHR;
    for (int task = gtid; task < 18 * 2 * 2048; task += NGT) {
        const int sq = task >> 12, dir = (task >> 11) & 1, ch = task & 2047;
        int row0, T; float h;
        if (sq < 16) { row0 = sq * 256; T = 256; h = 0.f; } else { row0 = MP + (sq - 16) * 2048; T = 2048; h = a.in[zz + I_STATE][((size_t)((sq - 16) * 2 + jl) * 2 + dir) * 2048 + ch]; }
        const float* A = (const float*)(ws + (dir ? WS_NAB : WS_NAF)); float* U = (float*)(ws + (dir ? WS_NUB : WS_NUF));
        for (int tt = 0; tt < T; tt += 8) {
            float av[8], uv[8];
#pragma unroll
            for (int e = 0; e < 8; ++e) { const int t = dir ? (T - 1 - tt - e) : (tt + e); av[e] = A[(size_t)(row0 + t) * 2048 + ch]; uv[e] = U[(size_t)(row0 + t) * 2048 + ch]; }
#pragma unroll
            for (int e = 0; e < 8; ++e) { const int t = dir ? (T - 1 - tt - e) : (tt + e); h = av[e] * h + uv[e]; U[(size_t)(row0 + t) * 2048 + ch] = h; }
        }
        if (sq < 16) out[OUT_ST + ((size_t)(sq * 2 + jl) * 2 + dir) * 2048 + ch] = h;
    }
}
__device__ __forceinline__ void ph_rg_y_naive(const Args& a, int zz, int tid, int G) {
    PH_LOCALS;
    const int gtid = blockIdx.x * NTHR + tid, NGT = G * NTHR;
    const float* UF = (const float*)(ws + WS_NUF); const float* UB = (const float*)(ws + WS_NUB); const bf16* GT = (const bf16*)(ws + WS_GATE); bf16* MIX = (bf16*)(ws + WS_MIX);
    for (int task = gtid; task < M * 2048 / 8; task += NGT) {
        const size_t e = (size_t)task * 8;
        const f32x4 f0 = *(const f32x4*)(UF + e), f1 = *(const f32x4*)(UF + e + 4), b0 = *(const f32x4*)(UB + e), b1 = *(const f32x4*)(UB + e + 4);
        const v4u g = *(const v4u*)(GT + e);
        f32x4 g0, g1; g0.x = __builtin_bit_cast(float, g.x << 16); g0.y = __builtin_bit_cast(float, g.x & 0xffff0000u); g0.z = __builtin_bit_cast(float, g.y << 16); g0.w = __builtin_bit_cast(float, g.y & 0xffff0000u);
        g1.x = __builtin_bit_cast(float, g.z << 16); g1.y = __builtin_bit_cast(float, g.z & 0xffff0000u); g1.z = __builtin_bit_cast(float, g.w << 16); g1.w = __builtin_bit_cast(float, g.w & 0xffff0000u);
        *(v4u*)(MIX + e) = pack8((f0 + b0) * g0, (f1 + b1) * g1);
    }
}
#endif

#if MK_NAIVE_ATTN
__device__ __forceinline__ void ph_attn_naive(const Args& a, int zz, int j, int tid, int G) {
    PH_LOCALS;
    const int gtid = blockIdx.x * NTHR + tid, NGT = G * NTHR;
    const bf16* QB = (const bf16*)(ws + WS_QB); bf16* OB = (bf16*)(ws + WS_MIX);
    const bf16* KP = (const bf16*)(ws + WS_KP); const bf16* VP = (const bf16*)(ws + WS_VP);
    const bf16* KSj = (const bf16*)(ws + WS_KS) + (size_t)j * 2 * 2560 * 512; const bf16* VSj = (const bf16*)(ws + WS_VS) + (size_t)j * 2 * 2560 * 512;
    constexpr float C = 0.088388347648318440f * 1.4426950408889634f;
    for (int lt = gtid; lt < M * 64; lt += NGT) {
        const int sub = lt & 3, h = (lt >> 2) & 15, row = lt >> 6, kvh = h >> 2;
        const bf16* Kb; const bf16* Vb; int nk;
        if (row < MP) { const int b = row >> 8; Kb = KP + (size_t)(b * 256) * 512 + kvh * 128 + sub * 32; Vb = VP + (size_t)(b * 256) * 512 + kvh * 128 + sub * 32; nk = 256; }
        else { const int b = (row - MP) >> 11; Kb = KSj + (size_t)(b * 2560) * 512 + kvh * 128 + sub * 32; Vb = VSj + (size_t)(b * 2560) * 512 + kvh * 128 + sub * 32; nk = 2560; }
        float q[32], o[32];
        { const bf16* qp = QB + (size_t)row * D + h * 128 + sub * 32;
#pragma unroll
          for (int d = 0; d < 32; ++d) { q[d] = bf2f(qp[d]) * C; o[d] = 0.f; } }
        float m = -1e30f, l = 0.f;
        for (int kk = 0; kk < nk; ++kk) {
            const v4u* kp = (const v4u*)(Kb + (size_t)kk * 512); const v4u* vp = (const v4u*)(Vb + (size_t)kk * 512);
            float s = 0.f;
#pragma unroll
            for (int c = 0; c < 4; ++c) { const v4u w = kp[c];
                s += q[8 * c + 0] * __builtin_bit_cast(float, w.x << 16) + q[8 * c + 1] * __builtin_bit_cast(float, w.x & 0xffff0000u) + q[8 * c + 2] * __builtin_bit_cast(float, w.y << 16) + q[8 * c + 3] * __builtin_bit_cast(float, w.y & 0xffff0000u)
                   + q[8 * c + 4] * __builtin_bit_cast(float, w.z << 16) + q[8 * c + 5] * __builtin_bit_cast(float, w.z & 0xffff0000u) + q[8 * c + 6] * __builtin_bit_cast(float, w.w << 16) + q[8 * c + 7] * __builtin_bit_cast(float, w.w & 0xffff0000u); }
            s += __shfl_xor(s, 1); s += __shfl_xor(s, 2);
            const float mn = fmaxf(m, s), al = __builtin_amdgcn_exp2f(m - mn), p = __builtin_amdgcn_exp2f(s - mn);
            l = l * al + p; m = mn;
#pragma unroll
            for (int c = 0; c < 4; ++c) { const v4u w = vp[c];
                o[8 * c + 0] = o[8 * c + 0] * al + p * __builtin_bit_cast(float, w.x << 16); o[8 * c + 1] = o[8 * c + 1] * al + p * __builtin_bit_cast(float, w.x & 0xffff0000u);
                o[8 * c + 2] = o[8 * c + 2] * al + p * __builtin_bit_cast(float, w.y << 16); o[8 * c + 3] = o[8 * c + 3] * al + p * __builtin_bit_cast(float, w.y & 0xffff0000u);
                o[8 * c + 4] = o[8 * c + 4] * al + p * __builtin_bit_cast(float, w.z << 16); o[8 * c + 5] = o[8 * c + 5] * al + p * __builtin_bit_cast(float, w.z & 0xffff0000u);
                o[8 * c + 6] = o[8 * c + 6] * al + p * __builtin_bit_cast(float, w.w << 16); o[8 * c + 7] = o[8 * c + 7] * al + p * __builtin_bit_cast(float, w.w & 0xffff0000u); }
        }
        const float il = 1.f / l;
        bf16* op = OB + (size_t)row * D + h * 128 + sub * 32;
#pragma unroll
        for (int c = 0; c < 4; ++c) { f32x4 x0 = {o[8 * c] * il, o[8 * c + 1] * il, o[8 * c + 2] * il, o[8 * c + 3] * il}, x1 = {o[8 * c + 4] * il, o[8 * c + 5] * il, o[8 * c + 6] * il, o[8 * c + 7] * il}; *(v4u*)(op + 8 * c) = pack8(x0, x1); }
    }
}
#endif

__global__ void __launch_bounds__(NTHR, 2) mk_fwd(Args args) {
    extern __shared__ __attribute__((aligned(16))) unsigned char lds_raw[];
    LAS unsigned char* lds = (LAS unsigned char*)lds_raw;
    if (threadIdx.x < 128) ((LAS unsigned*)(lds + LDSCTL_OFF))[threadIdx.x] = 0u;
    __syncthreads();
    const XcdBarrier bar = xcd_barrier_post((unsigned*)(args.ws + WS_CTL) + 4096, (volatile LAS unsigned*)(lds + LDSCTL_OFF));
    const int lo = args.ph_lo, hi = args.ph_hi;
#define RUN(p) (lo <= (p) && (p) < hi)
#define PH_BEGIN int zz = 0; asm volatile("" : "+s"(zz)); int tid = threadIdx.x; asm volatile("" : "+v"(tid)); const int lane = tid & 63, wave = __builtin_amdgcn_readfirstlane(tid >> 6); \
    unsigned char* const ws = args.ws + zz; const int G = (int)gridDim.x + zz; (void)lane; (void)wave; (void)ws; (void)G
#define SEAM(p) do { if ((p) + 1 < hi) { XcdBarrier b2 = bar; b2.bar = bar.bar + zz; xcd_barrier(b2); } } while (0)

    if (RUN(0)) { PH_BEGIN; ph_prologue(args, zz, lds, tid, lane, wave, G); SEAM(0); }
    if (RUN(1)) { PH_BEGIN; ph_modreduce(args, zz, tid, G); SEAM(1); }
    if (RUN(2)) { PH_BEGIN; ph_pre0(args, zz, lane, wave, G); SEAM(2); }

#pragma unroll 1
    for (int l = 0; l < NL; ++l) {
        const int pb = 3 + 10 * l, j = l >> 1;
        if ((l & 1) == 0) {
            if (RUN(pb + 0)) { PH_BEGIN;
                pg8::Gemm g{(const pg8::bf16_t*)(ws + WS_XN), (const pg8::bf16_t*)(ws + WS_WRGINT) + (size_t)j * RGW * D, M, RGW, D}; pg8::StaticOrder S; S.init(M, RGW, G, (int)blockIdx.x);
                pg8::EpiRgIn E{(pg8::bf16_t*)(ws + WS_GATE), (float*)(ws + WS_XB)};
                pg8::gemm_phase<pg8::EpiRgIn, pg8::StaticOrder, true, true>(lds, g, S, E);
                SEAM(pb + 0);
            }
#if MK_NAIVE_RG
            if (RUN(pb + 1)) { PH_BEGIN; ph_rg_conv_naive(args, zz, j, tid, G); SEAM(pb + 1); }
            if (RUN(pb + 2)) { PH_BEGIN; ph_rg_gates_naive(args, zz, j, tid, G); SEAM(pb + 2); }
            if (RUN(pb + 3)) { PH_BEGIN; ph_rg_scan_naive(args, zz, j, tid, G); SEAM(pb + 3); }
            if (RUN(pb + 4)) { PH_BEGIN; ph_rg_y_naive(args, zz, tid, G); SEAM(pb + 4); }
#else
            if (RUN(pb + 2)) { PH_BEGIN; ph_rg_fused(args, zz, j, lds, tid, lane, wave, G); SEAM(pb + 2); }
#endif
        } else {
            if (RUN(pb + 0)) { PH_BEGIN;
                pg8::Gemm g{(const pg8::bf16_t*)(ws + WS_XN), (const pg8::bf16_t*)(ws + WS_WQKVT) + (size_t)j * NQKV * D, M, NQKV, D}; pg8::StaticOrder S; S.init(M, NQKV, G, (int)blockIdx.x);
                pg8::EpiF32 E{(float*)(ws + WS_QKV), NQKV};
                pg8::gemm_phase<pg8::EpiF32, pg8::StaticOrder, true, true>(lds, g, S, E);
                SEAM(pb + 0);
            }
            if (RUN(pb + 1)) { PH_BEGIN; ph_qknorm(args, zz, j, lane, wave, G); SEAM(pb + 1); }
            if (RUN(pb + 2)) { PH_BEGIN;
#if MK_NAIVE_ATTN
                ph_attn_naive(args, zz, j, tid, G);
#else
                ph_attn(args, zz, j, lds_raw, tid, G);
#endif
                SEAM(pb + 2);
            }
        }
        if (RUN(pb + 5)) { PH_BEGIN;
            const pg8::bf16_t* Wt = (l & 1) ? (const pg8::bf16_t*)(ws + WS_WOT) + (size_t)j * D * D : (const pg8::bf16_t*)(ws + WS_WRGOUTT) + (size_t)j * D * D;
            pg8::Gemm g{(const pg8::bf16_t*)(ws + WS_MIX), Wt, M, D, D}; pg8::StaticOrder S; S.init(M, D, G, (int)blockIdx.x);
            pg8::EpiF32 E{(float*)(ws + WS_BR), D};
            pg8::gemm_phase<pg8::EpiF32, pg8::StaticOrder, true, true>(lds, g, S, E);
            SEAM(pb + 5);
        }
        if (RUN(pb + 6)) { PH_BEGIN; ph_post(args, zz, l, 0, lane, wave, G); SEAM(pb + 6); }
        if (RUN(pb + 7)) { PH_BEGIN;
            pg8::Gemm g{(const pg8::bf16_t*)(ws + WS_XN), (const pg8::bf16_t*)(ws + WS_W1T) + (size_t)l * FF * D, M, FF, D}; pg8::StaticOrder S; S.init(M, FF, G, (int)blockIdx.x);
            pg8::EpiRelu2 E{(pg8::bf16_t*)(ws + WS_H), FF};
            pg8::gemm_phase<pg8::EpiRelu2, pg8::StaticOrder, true, true>(lds, g, S, E);
            SEAM(pb + 7);
        }
        if (RUN(pb + 8)) { PH_BEGIN;
            pg8::Gemm g{(const pg8::bf16_t*)(ws + WS_H), (const pg8::bf16_t*)(ws + WS_W2T) + (size_t)l * D * FF, M, D, FF}; pg8::StaticOrder S; S.init(M, D, G, (int)blockIdx.x);
            pg8::EpiF32 E{(float*)(ws + WS_BR), D};
            pg8::gemm_phase<pg8::EpiF32, pg8::StaticOrder, true, true>(lds, g, S, E);
            SEAM(pb + 8);
        }
        if (RUN(pb + 9)) { PH_BEGIN; ph_post(args, zz, l, 1, lane, wave, G); SEAM(pb + 9); }
    }
#undef RUN
#undef SEAM
#undef PH_BEGIN
}

extern "C" void kernel_launch(void* const* d_in, const int* in_sizes, int n_in, void* d_out, int out_size, void* d_ws, size_t ws_size, hipStream_t stream) {
    static int grid = 0;
    if (grid == 0) {
        if (n_in != N_IN || out_size != OUT_TOTAL || ws_size < WS_END) { fprintf(stderr, "kernel_launch: built for %d inputs, %d outputs, >= %zu bytes of workspace; got %d, %d, %zu; nothing launched\n", (int)N_IN, OUT_TOTAL, (size_t)WS_END, n_in, out_size, ws_size); grid = -1; return; }
        int dev = 0, cus = 0, per_cu = 0;
        if (hipGetDevice(&dev) != hipSuccess || hipDeviceGetAttribute(&cus, hipDeviceAttributeMultiprocessorCount, dev) != hipSuccess) { fprintf(stderr, "kernel_launch: device query failed\n"); grid = -1; return; }
        if (hipFuncSetAttribute((const void*)mk_fwd, hipFuncAttributeMaxDynamicSharedMemorySize, LDS_BYTES) != hipSuccess) { fprintf(stderr, "kernel_launch: hipFuncSetAttribute failed\n"); grid = -1; return; }
        if (hipOccupancyMaxActiveBlocksPerMultiprocessor(&per_cu, (const void*)mk_fwd, NTHR, LDS_BYTES) != hipSuccess || per_cu < 1) fprintf(stderr, "kernel_launch: note: occupancy query reports %d workgroups per CU\n", per_cu);
        (void)hipGetLastError();
        grid = cus;
    }
    if (grid < 0) return;
    if (hipMemsetAsync((char*)d_ws + WS_CTL, 0, CTL_ZERO_BYTES, stream) != hipSuccess) { fprintf(stderr, "kernel_launch: memset failed\n"); return; }
    Args a{};
    for (int i = 0; i < N_IN; ++i) a.in[i] = (const float*)d_in[i];
    a.out = (float*)d_out; a.ws = (unsigned char*)d_ws;
#if MK_ONE_LAUNCH
    a.ph_lo = 0; a.ph_hi = NPH;
    hipLaunchKernelGGL(mk_fwd, dim3(grid), dim3(NTHR), LDS_BYTES, stream, a);
#else
    for (int p = 0; p < NPH; ++p) {
        if (!phase_active(p)) continue;
        a.ph_lo = p; a.ph_hi = p + 1;
        hipLaunchKernelGGL(mk_fwd, dim3(grid), dim3(NTHR), LDS_BYTES, stream, a);
    }
#endif
    const hipError_t le = hipPeekAtLastError();
    if (le != hipSuccess) fprintf(stderr, "kernel_launch: launch failed: %s\n", hipGetErrorName(le));
}
```

```cpp
#include <hip/hip_runtime.h>
#include <hip/hip_bf16.h>
#include <cstdio>
#include <cstdint>

#ifndef MK_ONE_LAUNCH
#define MK_ONE_LAUNCH 1
#endif
#ifndef MK_NAIVE_RG
#define MK_NAIVE_RG 0
#endif
#ifndef MK_NAIVE_ATTN
#define MK_NAIVE_ATTN 0
#endif
#ifndef MK_REP_GEMM
#define MK_REP_GEMM 1
#endif
#define MK_REP_PRO 1
#define MK_REP_PRO_T 1
#define MK_REP_PRO_G 1
#define MK_REP_RG 1
#define MK_REP_QK 1
#define MK_REP_ATT 1
#define MK_REP_POST 1
#define MK_REP_BAR 1
#ifndef MK_ST_SC1
#define MK_ST_SC1 0
#endif
#ifndef MK_SP2
#define MK_SP2 true
#endif
#ifndef MK_ALIGN
#define MK_ALIGN true
#endif
#ifndef MK_ST_NT
#define MK_ST_NT 0
#endif
#define MK_REP_FF1 1
#define MK_REP_FF2 1
#ifndef MK_H_SC1
#define MK_H_SC1 0
#endif
namespace pg8 {
#define PG8_LAS __attribute__((address_space(3)))
typedef unsigned short bf16_t;
typedef short bf16x8 __attribute__((ext_vector_type(8)));
typedef float f32x4 __attribute__((ext_vector_type(4)));
typedef unsigned u32x4 __attribute__((ext_vector_type(4)));
constexpr int BM = 256, BK = 64, HALF = 128, HTB = HALF * BK * 2  , STAGE_BYTES = 8 * HTB, NXCD = 8, WGM = 8;

__host__ __device__ __forceinline__ int lds_byte(int r, int c) { const int st = (r >> 4) * 2 + (c >> 5), rr = r & 15, cc = c & 31, ob = rr * 64 + cc * 2; return st * 1024 + (ob ^ (((ob >> 9) & 1) << 5)); }
__host__ __device__ __forceinline__ void stage_rc(int b, int& R, int& C) { const int st = b / 1024, sb = b % 1024, swz = sb ^ (((sb >> 9) & 1) << 5); R = (st >> 1) * 16 + swz / 64; C = (st & 1) * 32 + (swz % 64) / 2; }
__host__ __device__ __forceinline__ int perm32(int rho) { const int n = rho >> 4, i = rho & 15; return 8 * (i >> 2) + 4 * n + (i & 3); }

struct Unit { int pm, pn; };
struct Gemm { const bf16_t* A; const bf16_t* Bt; int M, N, K; };

struct StaticOrder {
    int nM, nN, nwg, G, c;
    __host__ __device__ void init(int M, int N, int G_, int c_) { nM = M / BM; nN = N / BM; nwg = nM * nN; G = G_; c = c_; }
    __host__ __device__ bool next(int i, Unit& u) const {
        const long L = (long)i * G + c; if (L >= nwg) return false;
        int wgid = (int)L; { const int q = nwg / NXCD, r = nwg % NXCD, xcd = wgid % NXCD, off = wgid / NXCD; wgid = (xcd < r ? xcd * (q + 1) : r * (q + 1) + (xcd - r) * q) + off; }
        const int nig = WGM * nN, gid = wgid / nig, fm = gid * WGM, gsz = (nM - fm) < WGM ? (nM - fm) : WGM;
        u.pm = fm + ((wgid % nig) % gsz); u.pn = (wgid % nig) / gsz; return true;
    }
    __device__ __forceinline__ void a_ready(const Unit&) const {}
    __device__ __forceinline__ void done(const Unit&) const {}
};

__device__ __forceinline__ unsigned cvt_pk_bf16(float lo, float hi) { unsigned r; asm volatile("v_cvt_pk_bf16_f32 %0, %1, %2" : "=v"(r) : "v"(lo), "v"(hi)); return r; }
typedef float f32x2 __attribute__((ext_vector_type(2)));
#if MK_ST_SC1
__device__ __forceinline__ void st16(void* p, u32x4 v) { asm volatile("global_store_dwordx4 %0, %1, off sc1\n\ts_nop 1" :: "v"(p), "v"(v) : "memory"); }
#elif MK_ST_NT
__device__ __forceinline__ void st16(void* p, u32x4 v) { __builtin_nontemporal_store(v, (u32x4*)p); }
#else
__device__ __forceinline__ void st16(void* p, u32x4 v) { *(u32x4*)p = v; }
#endif
__device__ __forceinline__ void st16_sc1(void* p, u32x4 v) { asm volatile("global_store_dwordx4 %0, %1, off sc1\n\ts_nop 1" :: "v"(p), "v"(v) : "memory"); }
__device__ __forceinline__ void st16f(void* p, f32x4 v) { st16(p, __builtin_bit_cast(u32x4, v)); }
struct EpiF32 {
    static constexpr bool PERM = false, AFTER_DRAIN = false;
    float* C; int ldc;
    __device__ __forceinline__ void operator()(const f32x4 (&acc)[2][2][4][2], const Unit& u, int wr, int wc, int fr, int fq) const {
        const int row0 = u.pm * BM + wr * 64 + fr, col0 = u.pn * BM + wc * 32 + 4 * fq;
#pragma unroll
        for (int ai = 0; ai < 2; ++ai)
#pragma unroll
            for (int m = 0; m < 4; ++m) { float* rowp = C + (size_t)(row0 + ai * HALF + m * 16) * ldc + col0;
#pragma unroll
                for (int bj = 0; bj < 2; ++bj)
#pragma unroll
                    for (int n = 0; n < 2; ++n) st16f(rowp + bj * HALF + n * 16, acc[ai][bj][m][n]); }
    }
};
template <bool RELU2> struct EpiBf16T {
    static constexpr bool PERM = true, AFTER_DRAIN = false;
    bf16_t* O; int ldc;
    __device__ __forceinline__ void operator()(const f32x4 (&acc)[2][2][4][2], const Unit& u, int wr, int wc, int fr, int fq) const {
        const int row0 = u.pm * BM + wr * 64 + fr, col0 = u.pn * BM + wc * 32 + 8 * fq;
#pragma unroll
        for (int ai = 0; ai < 2; ++ai)
#pragma unroll
            for (int m = 0; m < 4; ++m) { bf16_t* rowp = O + (size_t)(row0 + ai * HALF + m * 16) * ldc + col0;
#pragma unroll
                for (int bj = 0; bj < 2; ++bj) { f32x4 v0 = acc[ai][bj][m][0], v1 = acc[ai][bj][m][1];
                    if (RELU2) { v0 = __builtin_elementwise_max(v0, (f32x4){0.f, 0.f, 0.f, 0.f}); v1 = __builtin_elementwise_max(v1, (f32x4){0.f, 0.f, 0.f, 0.f}); v0 = v0 * v0; v1 = v1 * v1; }
                    u32x4 w; w.x = cvt_pk_bf16(v0[0], v0[1]); w.y = cvt_pk_bf16(v0[2], v0[3]); w.z = cvt_pk_bf16(v1[0], v1[1]); w.w = cvt_pk_bf16(v1[2], v1[3]);
                    if (RELU2 && MK_H_SC1) st16_sc1(rowp + bj * HALF, w); else st16(rowp + bj * HALF, w); } }
    }
};
__device__ __forceinline__ float gelu_tanh_f(float v) {
    const float u = v * (0.7978845608028654f + 0.035677408136300125f * v * v);
    const float t = __builtin_amdgcn_exp2f(-2.885390081777927f * u);
    return v * __builtin_amdgcn_rcpf(1.0f + t);
}
struct EpiRgIn {
    static constexpr bool PERM = true, AFTER_DRAIN = false;
    bf16_t* G; bf16_t* XB;
    __device__ __forceinline__ void operator()(const f32x4 (&acc)[2][2][4][2], const Unit& u, int wr, int wc, int fr, int fq) const {
        const int row0 = u.pm * BM + wr * 64 + fr;
        if (u.pn < 8) {
            const int col0 = u.pn * BM + wc * 32 + 8 * fq;
#pragma unroll
            for (int ai = 0; ai < 2; ++ai)
#pragma unroll
                for (int m = 0; m < 4; ++m) { bf16_t* rowp = G + (size_t)(row0 + ai * HALF + m * 16) * 2048 + col0;
#pragma unroll
                    for (int bj = 0; bj < 2; ++bj) { const f32x4 v0 = acc[ai][bj][m][0], v1 = acc[ai][bj][m][1];
                        u32x4 w; w.x = cvt_pk_bf16(gelu_tanh_f(v0[0]), gelu_tanh_f(v0[1])); w.y = cvt_pk_bf16(gelu_tanh_f(v0[2]), gelu_tanh_f(v0[3]));
                        w.z = cvt_pk_bf16(gelu_tanh_f(v1[0]), gelu_tanh_f(v1[1])); w.w = cvt_pk_bf16(gelu_tanh_f(v1[2]), gelu_tanh_f(v1[3]));
                        st16(rowp + bj * HALF, w); } }
        } else {
            const int col0 = (u.pn - 8) * BM + wc * 32 + 8 * fq;
#pragma unroll
            for (int ai = 0; ai < 2; ++ai)
#pragma unroll
                for (int m = 0; m < 4; ++m) { bf16_t* rowp = XB + (size_t)(row0 + ai * HALF + m * 16) * 2048 + col0;
#pragma unroll
                    for (int bj = 0; bj < 2; ++bj) { const f32x4 v0 = acc[ai][bj][m][0], v1 = acc[ai][bj][m][1];
                        u32x4 w; w.x = cvt_pk_bf16(v0[0], v0[1]); w.y = cvt_pk_bf16(v0[2], v0[3]); w.z = cvt_pk_bf16(v1[0], v1[1]); w.w = cvt_pk_bf16(v1[2], v1[3]);
                        st16(rowp + bj * HALF, w); } }
        }
    }
};
template <class Epi, class Sched, bool ALIGN_EPI = false, bool SP2 = false>
__device__ __forceinline__ void gemm_phase(PG8_LAS unsigned char* lds, const Gemm g, const Sched& S, const Epi& E, const int wave_id) {
    const int wid = __builtin_amdgcn_readfirstlane(wave_id); int lane_l = (int)__builtin_amdgcn_mbcnt_hi(~0u, __builtin_amdgcn_mbcnt_lo(~0u, 0u)); asm volatile("" : "+v"(lane_l)); const int tid = wid * 64 + lane_l, lane = tid & 63, wr = wid >> 2, wc = wid & 3, fr = lane & 15, fq = lane >> 4;
    const int K = g.K, nt = K / BK;
    unsigned voffA[2], voffB[2];
#pragma unroll
    for (int i = 0; i < 2; ++i) { int R, C; stage_rc(tid * 16 + i * 8192, R, C); const int Rb = Epi::PERM ? ((R & ~31) + perm32(R & 31)) : R;
        voffA[i] = (unsigned)(R * K + C) * 2u; voffB[i] = (unsigned)(Rb * K + C) * 2u; }
    const size_t kstep = (size_t)(BK * 2);
    const size_t hstep = (size_t)HALF * K * 2;
    const size_t tstep = 2 * hstep;
    const unsigned ldsw = (unsigned)wid * 1024u;
    const int aoff = lds_byte(wr * 64 + fr, fq * 8), boff = lds_byte(wc * 32 + fr, fq * 8);
#define PG8_SA(b, h) (((b) * 2 + (h)) * HTB)
#define PG8_SB(b, h) ((4 + (b) * 2 + (h)) * HTB)
#define PG8_STAGE(bufoff, gbase, voff) do { _Pragma("unroll") for (int _i = 0; _i < 2; ++_i) \
        __builtin_amdgcn_global_load_lds((const unsigned*)((const char*)(gbase) + (voff)[_i]), (PG8_LAS unsigned*)(lds + (bufoff) + ldsw + _i * 8192), 16, 0, 0); } while (0)
#define PG8_LDA(dst, b, h) do { _Pragma("unroll") for (int m = 0; m < 4; ++m) _Pragma("unroll") for (int k = 0; k < 2; ++k) dst[m][k] = *(const PG8_LAS bf16x8*)(lds + PG8_SA(b, h) + aoff + m * 2048 + k * 1024); } while (0)
#define PG8_LDB(dst, b, h) do { _Pragma("unroll") for (int n = 0; n < 2; ++n) _Pragma("unroll") for (int k = 0; k < 2; ++k) dst[n][k] = *(const PG8_LAS bf16x8*)(lds + PG8_SB(b, h) + boff + n * 2048 + k * 1024); } while (0)
#define PG8_MMA(ai, bj, At, Bt) do { __builtin_amdgcn_s_setprio(1); _Pragma("unroll") for (int m = 0; m < 4; ++m) _Pragma("unroll") for (int n = 0; n < 2; ++n) _Pragma("unroll") for (int k = 0; k < 2; ++k) \
        acc[ai][bj][m][n] = __builtin_amdgcn_mfma_f32_16x16x32_bf16(Bt[n][k], At[m][k], acc[ai][bj][m][n], 0, 0, 0); __builtin_amdgcn_s_setprio(0); } while (0)
#define PG8_WAIT_V(n) asm volatile("s_waitcnt vmcnt(" #n ")" ::: "memory")
#define PG8_WAIT_L(n) asm volatile("s_waitcnt lgkmcnt(" #n ")" ::: "memory")
#define PG8_BAR __builtin_amdgcn_s_barrier()
#define PG8_SCHED __builtin_amdgcn_sched_barrier(0)
    Unit cur, nxt; int ui = 0;
    if (!S.next(0, cur)) return;
    f32x4 acc[2][2][4][2];
#pragma unroll
    for (int a = 0; a < 2; ++a)
#pragma unroll
        for (int b = 0; b < 2; ++b)
#pragma unroll
            for (int m = 0; m < 4; ++m)
#pragma unroll
                for (int n = 0; n < 2; ++n) acc[a][b][m][n] = (f32x4){0.f, 0.f, 0.f, 0.f};
    bf16x8 At[4][2], B0[2][2], B1[2][2];
    const char* cA = (const char*)g.A + (size_t)cur.pm * tstep; const char* cB = (const char*)g.Bt + (size_t)cur.pn * tstep;
    S.a_ready(cur);
    if constexpr (SP2) {
        PG8_STAGE(PG8_SB(0, 0), cB, voffB); PG8_STAGE(PG8_SB(0, 1), cB + hstep, voffB); PG8_STAGE(PG8_SA(0, 0), cA, voffA); PG8_STAGE(PG8_SA(0, 1), cA + hstep, voffA);
        if (wr == 1) PG8_BAR;
        PG8_WAIT_V(2); PG8_BAR;
        PG8_STAGE(PG8_SB(1, 0), cB + kstep, voffB); PG8_STAGE(PG8_SA(1, 0), cA + kstep, voffA); PG8_STAGE(PG8_SB(1, 1), cB + hstep + kstep, voffB);
        PG8_WAIT_V(6); PG8_BAR;
    } else {
        PG8_STAGE(PG8_SB(0, 0), cB, voffB); PG8_STAGE(PG8_SA(0, 0), cA, voffA); PG8_STAGE(PG8_SB(0, 1), cB + hstep, voffB); PG8_STAGE(PG8_SA(0, 1), cA + hstep, voffA);
        if (wr == 1) PG8_BAR;
        PG8_WAIT_V(4); PG8_BAR;
        PG8_STAGE(PG8_SB(1, 0), cB + kstep, voffB); PG8_STAGE(PG8_SA(1, 0), cA + kstep, voffA); PG8_STAGE(PG8_SB(1, 1), cB + hstep + kstep, voffB);
        PG8_WAIT_V(6); PG8_BAR;
    }
    for (;;) {
        const bool has_next = S.next(ui + 1, nxt);
        const char* nA = has_next ? (const char*)g.A + (size_t)nxt.pm * tstep : cA; const char* nB = has_next ? (const char*)g.Bt + (size_t)nxt.pn * tstep : cB;
        for (int t = 0; t < nt; t += 2) {
            const bool last = (t == nt - 2);
            const char* a1 = cA + (size_t)(t + 1) * kstep;
            const char* a2 = last ? nA : cA + (size_t)(t + 2) * kstep; const char* b2 = last ? nB : cB + (size_t)(t + 2) * kstep;
            const char* a3 = a2 + kstep; const char* b3 = b2 + kstep;
            if (last && has_next) S.a_ready(nxt);
            if constexpr (SP2) {
            PG8_LDB(B0, 0, 0); PG8_LDB(B1, 0, 1); PG8_SCHED; PG8_LDA(At, 0, 0); PG8_STAGE(PG8_SA(1, 1), a1 + hstep, voffA);
            PG8_WAIT_V(8); PG8_WAIT_L(0); PG8_BAR; PG8_MMA(0, 0, At, B0); PG8_MMA(0, 1, At, B1); PG8_BAR; PG8_SCHED;
            PG8_LDA(At, 0, 1); PG8_STAGE(PG8_SB(0, 0), b2, voffB); PG8_STAGE(PG8_SB(0, 1), b2 + hstep, voffB); PG8_STAGE(PG8_SA(0, 0), a2, voffA);
            PG8_WAIT_V(8); PG8_WAIT_L(0); PG8_BAR; PG8_MMA(1, 0, At, B0); PG8_MMA(1, 1, At, B1); PG8_BAR; PG8_SCHED;
            PG8_LDB(B0, 1, 0); PG8_LDB(B1, 1, 1); PG8_SCHED; PG8_LDA(At, 1, 0); PG8_STAGE(PG8_SA(0, 1), a2 + hstep, voffA);
            PG8_WAIT_V(8); PG8_WAIT_L(0); PG8_BAR; PG8_MMA(0, 0, At, B0); PG8_MMA(0, 1, At, B1); PG8_BAR; PG8_SCHED;
            PG8_LDA(At, 1, 1); PG8_STAGE(PG8_SB(1, 0), b3, voffB); PG8_STAGE(PG8_SB(1, 1), b3 + hstep, voffB); PG8_STAGE(PG8_SA(1, 0), a3, voffA);
            PG8_WAIT_V(8); PG8_WAIT_L(0); PG8_BAR; PG8_MMA(1, 0, At, B0); PG8_MMA(1, 1, At, B1); PG8_BAR; PG8_SCHED;
            } else {
            PG8_LDB(B0, 0, 0); PG8_SCHED; PG8_LDA(At, 0, 0); PG8_STAGE(PG8_SA(1, 1), a1 + hstep, voffA);
            PG8_WAIT_L(8); PG8_BAR; PG8_WAIT_L(0); PG8_MMA(0, 0, At, B0); PG8_BAR; PG8_SCHED;
            PG8_LDB(B1, 0, 1); PG8_STAGE(PG8_SB(0, 0), b2, voffB);
            PG8_BAR; PG8_WAIT_L(0); PG8_MMA(0, 1, At, B1); PG8_BAR;
            PG8_LDA(At, 0, 1); PG8_STAGE(PG8_SA(0, 0), a2, voffA);
            PG8_BAR; PG8_WAIT_L(0); PG8_MMA(1, 0, At, B0); PG8_BAR; PG8_SCHED;
            PG8_STAGE(PG8_SB(0, 1), b2 + hstep, voffB);
            PG8_WAIT_V(6); PG8_BAR; PG8_MMA(1, 1, At, B1); PG8_BAR;
            PG8_LDB(B0, 1, 0); PG8_SCHED; PG8_LDA(At, 1, 0); PG8_STAGE(PG8_SA(0, 1), a2 + hstep, voffA);
            PG8_WAIT_L(8); PG8_BAR; PG8_WAIT_L(0); PG8_MMA(0, 0, At, B0); PG8_BAR; PG8_SCHED;
            PG8_LDB(B1, 1, 1); PG8_STAGE(PG8_SB(1, 0), b3, voffB);
            PG8_BAR; PG8_WAIT_L(0); PG8_MMA(0, 1, At, B1); PG8_BAR;
            PG8_LDA(At, 1, 1); PG8_STAGE(PG8_SA(1, 0), a3, voffA);
            PG8_BAR; PG8_WAIT_L(0); PG8_MMA(1, 0, At, B0); PG8_BAR; PG8_SCHED;
            PG8_STAGE(PG8_SB(1, 1), b3 + hstep, voffB);
            PG8_WAIT_V(6); PG8_BAR; PG8_MMA(1, 1, At, B1); PG8_BAR;
            }
        }
        if constexpr (ALIGN_EPI) { if (wr == 0) PG8_BAR; }
        if constexpr (!Epi::AFTER_DRAIN) { E(acc, cur, wr, wc, fr, fq); S.done(cur); }
        if (!has_next) break;
#pragma unroll
        for (int a = 0; a < 2; ++a)
#pragma unroll
            for (int b = 0; b < 2; ++b)
#pragma unroll
                for (int m = 0; m < 4; ++m)
#pragma unroll
                    for (int n = 0; n < 2; ++n) acc[a][b][m][n] = (f32x4){0.f, 0.f, 0.f, 0.f};
        cur = nxt; cA = nA; cB = nB; ++ui;
        if constexpr (ALIGN_EPI) { if (wr == 1) PG8_BAR; }
    }
    PG8_WAIT_V(0);
    if constexpr (!ALIGN_EPI) { if (wr == 0) PG8_BAR; }
    PG8_BAR;
    if constexpr (Epi::AFTER_DRAIN) { E.fused(acc, cur, wr, wc, fr, fq, lds, wid, lane); S.done(cur); }
#undef PG8_SA
#undef PG8_SB
#undef PG8_STAGE
#undef PG8_LDA
#undef PG8_LDB
#undef PG8_MMA
#undef PG8_WAIT_V
#undef PG8_WAIT_L
#undef PG8_BAR
#undef PG8_SCHED
}
}
#define GAS __attribute__((address_space(1)))
#define LAS __attribute__((address_space(3)))
typedef unsigned short bf16;
typedef unsigned v4u __attribute__((ext_vector_type(4)));
typedef float f32x4 __attribute__((ext_vector_type(4)));
typedef short bf16x8 __attribute__((ext_vector_type(8)));
typedef GAS unsigned gu32;
typedef GAS unsigned long long gu64;
#define RLX_AGENT __ATOMIC_RELAXED, __HIP_MEMORY_SCOPE_AGENT
#define LDS_WAIT() asm volatile("s_waitcnt lgkmcnt(0)" ::: "memory")
#define VM_WAIT() asm volatile("s_waitcnt vmcnt(0)" ::: "memory")
__device__ __forceinline__ unsigned long long rt() { return __builtin_amdgcn_s_memrealtime(); }
__device__ __forceinline__ unsigned f2bf(float f) { unsigned u = __builtin_bit_cast(unsigned, f); return (u + 0x7fffu + ((u >> 16) & 1u)) >> 16; }
__device__ __forceinline__ unsigned pk2(float lo, float hi) { return f2bf(lo) | (f2bf(hi) << 16); }
#define XB_TMO      128
#define XB_XCNT(j)  (256  + 64 * (j))
#define XB_XSUB(j)  (1280 + 64 * (j))
#define XB_XGEN(j)  (2304 + 64 * (j))
#define XB_TOP      3328
#define XB_TOPGEN   3392
#define XCD_BAR_WORDS 3456
#define XB_SPIN_CAP (1u << 18)

__device__ __forceinline__ unsigned xb_ld(unsigned* p)              { return __hip_atomic_load(p, __ATOMIC_RELAXED, __HIP_MEMORY_SCOPE_AGENT); }
__device__ __forceinline__ unsigned xb_add(unsigned* p, unsigned v) { return __hip_atomic_fetch_add(p, v, __ATOMIC_RELAXED, __HIP_MEMORY_SCOPE_AGENT); }
__device__ __forceinline__ unsigned xb_xcc_id() { return (unsigned)__builtin_amdgcn_s_getreg((3 << 11) | 20) & 0xFu; }
#define XB_SPIN(cond, bar) do { unsigned _sp = 0; while (cond) { __builtin_amdgcn_s_sleep(1); \
    if ((++_sp & 255u) == 0u) { if (xb_ld(&(bar)[XB_TMO])) break; if (_sp > XB_SPIN_CAP) { atomicAdd(&(bar)[XB_TMO], 1u); break; } } } } while (0)

struct XcdBarrier {
    unsigned* bar; unsigned x;
    volatile LAS unsigned* st;
};

__device__ __forceinline__ XcdBarrier xcd_barrier_post(unsigned* bar, volatile LAS unsigned* st) {
    XcdBarrier b; b.bar = bar; b.x = xb_xcc_id(); b.st = st;
    if (threadIdx.x == 0) (void)xb_add(&bar[XB_XCNT(b.x)], 1u);
    return b;
}
__device__ __forceinline__ void xcd_barrier_complete(unsigned* bar, unsigned x, unsigned& nloc, unsigned& nx) {
    const unsigned G = gridDim.x * gridDim.y * gridDim.z;
    unsigned sum, cnt, mine, sp = 0u;
    for (;;) {
        sum = 0u; cnt = 0u; mine = 0u;
#pragma unroll
        for (unsigned j = 0; j < 16; ++j) { const unsigned c = xb_ld(&bar[XB_XCNT(j)]); sum += c; cnt += (c > 0u) ? 1u : 0u; mine = (j == x) ? c : mine; }
        if (sum == G) break;
        __builtin_amdgcn_s_sleep(1);
        if ((++sp & 255u) == 0u) { if (xb_ld(&bar[XB_TMO])) break; if (sp > XB_SPIN_CAP) { atomicAdd(&bar[XB_TMO], 1u); break; } }
    }
    nloc = mine > 0u ? mine : 1u; nx = cnt > 0u ? cnt : 1u;
}

__device__ __forceinline__ void xcd_barrier(const XcdBarrier& b) {
    asm volatile("s_waitcnt vmcnt(0)" ::: "memory");
    __syncthreads();
    if (threadIdx.x == 0) {
        unsigned* bar = b.bar;
        __builtin_amdgcn_s_waitcnt(0);
        unsigned nloc = b.st[0], nx = b.st[1];
        if (nloc == 0u) { xcd_barrier_complete(bar, b.x, nloc, nx); b.st[0] = nloc; b.st[1] = nx; }
        const unsigned old = xb_add(&bar[XB_XSUB(b.x)], 1u);
        const unsigned gen = old / nloc;
        if (old + 1u == (gen + 1u) * nloc) {
            __builtin_amdgcn_fence(__ATOMIC_RELEASE, "agent");
            asm volatile("s_waitcnt vmcnt(0)" ::: "memory");
            const unsigned og = xb_add(&bar[XB_TOP], 1u);
            const unsigned tg = og / nx;
            if (og + 1u == (tg + 1u) * nx) xb_add(&bar[XB_TOPGEN], 1u);
            else XB_SPIN(xb_ld(&bar[XB_TOPGEN]) == tg, bar);
            __builtin_amdgcn_fence(__ATOMIC_ACQUIRE, "agent");
            xb_add(&bar[XB_XGEN(b.x)], 1u);
            asm volatile("s_waitcnt vmcnt(0)" ::: "memory");
        } else {
            XB_SPIN(xb_ld(&bar[XB_XGEN(b.x)]) == gen, bar);
            __builtin_amdgcn_fence(__ATOMIC_ACQUIRE, "agent");
            asm volatile("s_waitcnt vmcnt(0)" ::: "memory");
        }
    }
    __syncthreads();
}

constexpr int D = 2048, M = 8192, MP = 4096, FF = 8192, NQKV = 3072, RGW = 4096;
constexpr int NL = 4;
constexpr float EPS = 1e-6f;
constexpr int NWAVES = 8, NTHR = 512;
constexpr int OUT_ST = 2 * MP * D;
constexpr int OUT_CK = OUT_ST + 16 * 2 * 2 * 2048;
constexpr int OUT_CV = OUT_CK + 16 * 2 * 256 * 512;
constexpr int OUT_TOTAL = OUT_CV + 16 * 2 * 256 * 512;
enum { I_XP = 0, I_XS, I_STATE, I_CK, I_CV, I_C, I_CCTX, I_WMOD, I_BMOD, I_GPREMIX, I_GPOSTMIX, I_GPREFFN, I_GPOSTFFN, I_WQKV, I_GQ, I_GK, I_WO,
       I_WRGIN, I_CONVW, I_CONVB, I_WRGA, I_BRGA, I_WRGX, I_BRGX, I_LAM, I_WRGOUT, I_WFF1, I_WFF2, N_IN };

constexpr size_t MiB = 1u << 20;
constexpr size_t WS_CTL = 0, CTL_ZERO_BYTES = 1 * MiB;
constexpr size_t WS_MODP = 2 * MiB;
constexpr size_t WS_MODF = 5 * MiB;
constexpr size_t WS_ROPE = 6 * MiB;
constexpr size_t WS_W1T = 8 * MiB;
constexpr size_t WS_W2T = 136 * MiB;
constexpr size_t WS_WQKVT = 264 * MiB;
constexpr size_t WS_WOT = 288 * MiB;
constexpr size_t WS_WRGINT = 304 * MiB;
constexpr size_t WS_WRGOUTT = 336 * MiB;
constexpr size_t WS_XN = 352 * MiB;
constexpr size_t WS_BR = 384 * MiB;
constexpr size_t WS_H = 448 * MiB;
constexpr size_t WS_QKV = 576 * MiB;
constexpr size_t WS_QB = 672 * MiB;
constexpr size_t WS_MIX = 704 * MiB;
constexpr size_t WS_KP = 736 * MiB, WS_VP = 740 * MiB;
constexpr size_t WS_KS = 744 * MiB, WS_VS = 754 * MiB;
constexpr size_t WS_GATE = 764 * MiB;
constexpr size_t WS_XB = 796 * MiB;
constexpr size_t WS_HF = 860 * MiB;
constexpr size_t WS_XR = 892 * MiB;
constexpr size_t WS_DUMMY = 924 * MiB;
constexpr size_t WS_END = 924 * MiB + (MK_REP_POST > 1 ? 96 * MiB : 0);
constexpr size_t WS_NXC = WS_H, WS_NAF = WS_H + 64 * MiB, WS_NUF = WS_QKV, WS_NAB = WS_QKV + 64 * MiB, WS_NUB = WS_BR;

constexpr int LDS_BYTES = 147456;
constexpr int LDSCTL_OFF = LDS_BYTES - 512;

constexpr int NPH = 3 + 10 * NL;
__host__ __device__ inline bool phase_active(int p) {
    if (p < 3) return true;
    const int l = (p - 3) / 10, s = (p - 3) % 10; const bool rg = (l & 1) == 0;
    if (s == 1) return !rg || MK_NAIVE_RG;
    if (s == 3 || s == 4) return rg && MK_NAIVE_RG;
    return true;
}

struct Args { const float* in[N_IN]; float* out; unsigned char* ws; int ph_lo, ph_hi; };
#define PH_LOCALS unsigned char* const ws = a.ws + zz; float* const out = a.out + zz; (void)ws; (void)out

__device__ __forceinline__ float wave_sum(float v) {
#pragma unroll
    for (int o = 1; o < 64; o <<= 1) v += __shfl_xor(v, o);
    return v;
}
__device__ __forceinline__ int mod_idx(int row) { return row < MP ? 0 : 1 + ((row - MP) >> 11); }
__device__ __forceinline__ unsigned long long pack4(f32x4 v) { return (unsigned long long)pg8::cvt_pk_bf16(v.x, v.y) | ((unsigned long long)pg8::cvt_pk_bf16(v.z, v.w) << 32); }
__device__ __forceinline__ v4u pack8(f32x4 a, f32x4 b) { v4u w; w.x = pg8::cvt_pk_bf16(a.x, a.y); w.y = pg8::cvt_pk_bf16(a.z, a.w); w.z = pg8::cvt_pk_bf16(b.x, b.y); w.w = pg8::cvt_pk_bf16(b.z, b.w); return w; }
__device__ __forceinline__ float bf2f(unsigned short b) { return __builtin_bit_cast(float, (unsigned)b << 16); }
__device__ __forceinline__ float sigmoid_f(float x) { return __builtin_amdgcn_rcpf(1.0f + __builtin_amdgcn_exp2f(-1.4426950408889634f * x)); }

__device__ __forceinline__ void p0_transpose_item(const float* W, int K, int N, bf16* WT, LAS float* scr, int item, int lane) {
    const int nblk = N / 32, kb = item / nblk, nb = item % nblk, k0 = 64 * kb, n0 = 32 * nb;
#pragma unroll 8
    for (int i = 0; i < 32; ++i) { const int kk = 2 * i + (lane >> 5); scr[kk * 33 + (lane & 31)] = W[(size_t)(k0 + kk) * N + n0 + (lane & 31)]; }
    LDS_WAIT(); asm volatile("" ::: "memory");
    const int c = lane & 7;
#pragma unroll
    for (int j = 0; j < 4; ++j) { const int n = (lane >> 3) + 8 * j; const LAS float* s = scr + (8 * c) * 33 + n;
        v4u o; o.x = pk2(s[0 * 33], s[1 * 33]); o.y = pk2(s[2 * 33], s[3 * 33]); o.z = pk2(s[4 * 33], s[5 * 33]); o.w = pk2(s[6 * 33], s[7 * 33]);
        *(GAS v4u*)(WT + (size_t)(n0 + n) * K + k0 + 8 * c) = o; }
    LDS_WAIT(); asm volatile("" ::: "memory");
}
__constant__ float INV_FREQ[32] = {1.f, 0.749894261f, 0.562341332f, 0.421696514f, 0.316227764f, 0.237137377f, 0.177827939f, 0.133352131f, 0.100000001f, 0.0749894157f, 0.0562341325f, 0.0421696529f,
    0.0316227749f, 0.0237137377f, 0.0177827943f, 0.0133352149f, 0.00999999978f, 0.00749894185f, 0.00562341325f, 0.00421696482f, 0.00316227763f, 0.00237137359f, 0.00177827943f, 0.00133352145f,
    0.00100000005f, 0.000749894243f, 0.000562341302f, 0.000421696517f, 0.000316227757f, 0.00023713737f, 0.00017782794f, 0.00013335215f};
__device__ __forceinline__ void sincos_d(double a, double& s, double& c) {
    const double k = __builtin_rint(a * 0.6366197723675814);
    double r = __builtin_fma(-k, 1.5707963267948966, a); r = __builtin_fma(-k, 6.123233995736766e-17, r);
    const double r2 = r * r;
    double sp = -7.647163731819816e-13; sp = sp * r2 + 1.6059043836821613e-10; sp = sp * r2 - 2.505210838544172e-08; sp = sp * r2 + 2.7557319223985893e-06; sp = sp * r2 - 1.984126984126984e-04;
    sp = sp * r2 + 8.333333333333333e-03; sp = sp * r2 - 1.6666666666666666e-01; sp = r + r * r2 * sp;
    double cp = 4.779477332387385e-14; cp = cp * r2 - 1.1470745597729725e-11; cp = cp * r2 + 2.08767569878681e-09; cp = cp * r2 - 2.755731922398589e-07; cp = cp * r2 + 2.48015873015873e-05;
    cp = cp * r2 - 1.388888888888889e-03; cp = cp * r2 + 4.1666666666666664e-02; cp = cp * r2 - 0.5; cp = 1.0 + r2 * cp;
    const int q = (int)k & 3;
    s = (q == 0) ? sp : (q == 1) ? cp : (q == 2) ? -sp : -cp;
    c = (q == 0) ? cp : (q == 1) ? -sp : (q == 2) ? -cp : sp;
}
__device__ __forceinline__ void ph_prologue(const Args& a, int zz, LAS unsigned char* lds, int tid, int lane, int wave, int G) {
    PH_LOCALS;
    for (int rept_ = 0; rept_ < MK_REP_PRO_T; ++rept_) {
        const int n4 = tid & 63, wv = tid >> 6;
        struct Desc { const float* W; bf16* WT; int K, N, k0, n0; };
        f32x4 RA[2][8], RB[2][8]; Desc dA{nullptr, nullptr, 0, 0, 0, 0}, dB = dA;
#define P0_DESC(d, it_) do { int r_; const int it__ = (it_); \
            if (it__ < 2048)      { r_ = it__;        const int l_ = r_ >> 9; r_ &= 511; d.W = a.in[zz + I_WFF1] + (size_t)l_ * 2048 * 8192; d.K = 2048; d.N = 8192; d.WT = (bf16*)(ws + WS_W1T) + (size_t)l_ * 8192 * 2048; } \
            else if (it__ < 4096) { r_ = it__ - 2048; const int l_ = r_ >> 9; r_ &= 511; d.W = a.in[zz + I_WFF2] + (size_t)l_ * 8192 * 2048; d.K = 8192; d.N = 2048; d.WT = (bf16*)(ws + WS_W2T) + (size_t)l_ * 2048 * 8192; } \
            else if (it__ < 4480) { r_ = it__ - 4096; const int j_ = r_ / 192; r_ -= j_ * 192; d.W = a.in[zz + I_WQKV] + (size_t)j_ * 2048 * 3072; d.K = 2048; d.N = 3072; d.WT = (bf16*)(ws + WS_WQKVT) + (size_t)j_ * 3072 * 2048; } \
            else if (it__ < 4736) { r_ = it__ - 4480; const int j_ = r_ >> 7; r_ &= 127; d.W = a.in[zz + I_WO] + (size_t)j_ * 2048 * 2048; d.K = 2048; d.N = 2048; d.WT = (bf16*)(ws + WS_WOT) + (size_t)j_ * 2048 * 2048; } \
            else if (it__ < 5248) { r_ = it__ - 4736; const int j_ = r_ >> 8; r_ &= 255; d.W = a.in[zz + I_WRGIN] + (size_t)j_ * 2048 * 4096; d.K = 2048; d.N = 4096; d.WT = (bf16*)(ws + WS_WRGINT) + (size_t)j_ * 4096 * 2048; } \
            else                  { r_ = it__ - 5248; const int j_ = r_ >> 7; r_ &= 127; d.W = a.in[zz + I_WRGOUT] + (size_t)j_ * 2048 * 2048; d.K = 2048; d.N = 2048; d.WT = (bf16*)(ws + WS_WRGOUTT) + (size_t)j_ * 2048 * 2048; } \
            const int nblk_ = d.N >> 8, kb_ = r_ / nblk_, nb_ = r_ - kb_ * nblk_; d.k0 = 128 * kb_; d.n0 = 256 * nb_; } while (0)
#define P0_LOAD(R, d) do { _Pragma("unroll") for (int i = 0; i < 2; ++i) _Pragma("unroll") for (int e = 0; e < 8; ++e) \
            R[i][e] = __builtin_nontemporal_load((const f32x4*)(d.W + (size_t)(d.k0 + 8 * (wv + 8 * i) + e) * d.N + d.n0 + 4 * n4)); } while (0)
#define P0_ITEM(R, d, itv, buf) do { LAS unsigned char* img = lds + (buf) * 65536; \
            _Pragma("unroll") for (int i = 0; i < 2; ++i) _Pragma("unroll") for (int c = 0; c < 4; ++c) { const int row = 4 * n4 + c, chunk = (wv + 8 * i) ^ (n4 & 15); \
                v4u w; w.x = pg8::cvt_pk_bf16(R[i][0][c], R[i][1][c]); w.y = pg8::cvt_pk_bf16(R[i][2][c], R[i][3][c]); w.z = pg8::cvt_pk_bf16(R[i][4][c], R[i][5][c]); w.w = pg8::cvt_pk_bf16(R[i][6][c], R[i][7][c]); \
                *(LAS v4u*)(img + row * 256 + chunk * 16) = w; } \
            __syncthreads(); \
            bf16* WTc = d.WT; const int Kc = d.K, k0c = d.k0, n0c = d.n0; const bool valid_ = (itv) < 5504; \
            { const int nit_ = (itv) + 2 * G; P0_DESC(d, nit_ < 5504 ? nit_ : 5503); P0_LOAD(R, d); }     \
            if (valid_) { _Pragma("unroll") for (int rr = 0; rr < 8; ++rr) { const int row = rr * 32 + (tid >> 4), jp = tid & 15, j = jp ^ ((row >> 2) & 15); \
                const v4u v = *(const LAS v4u*)(img + row * 256 + jp * 16); \
                __builtin_nontemporal_store(v, (v4u*)(WTc + (size_t)(n0c + row) * Kc + k0c + 8 * j)); } } } while (0)
        int it = blockIdx.x;
        { P0_DESC(dA, it < 5504 ? it : 5503); P0_LOAD(RA, dA); }
        { P0_DESC(dB, it + G < 5504 ? it + G : 5503); P0_LOAD(RB, dB); }
        while (it < 5504) {
            P0_ITEM(RA, dA, it, 0);
            P0_ITEM(RB, dB, it + G, 1);
            it += 2 * G;
        }
        asm volatile("s_waitcnt vmcnt(0)" ::: "memory");
#undef P0_DESC
#undef P0_LOAD
#undef P0_ITEM
    }
    __syncthreads();
    for (int repg_ = 0; repg_ < MK_REP_PRO_G; ++repg_) {
        LAS float* S = (LAS float*)lds;
        LAS float* red = (LAS float*)(lds + 24576);
        for (int i = tid; i < 3 * 2048; i += NTHR) { const int ci = i >> 11, k = i & 2047; const float x = ci == 0 ? a.in[zz + I_CCTX][k] : a.in[zz + I_C][(ci - 1) * 2048 + k]; S[i] = x * sigmoid_f(x); }
        __syncthreads();
        float* MODP = (float*)(ws + WS_MODP);
        for (int bi = blockIdx.x; bi < 768; bi += G) {
            const int l = bi / 192, rem = bi % 192, cc = rem >> 2, kg = rem & 3, k0 = kg * 512 + wave * 64;
            const float* wp = a.in[zz + I_WMOD] + ((size_t)l * 2048 + k0) * 12288 + cc * 256 + lane * 4;
            f32x4 a0 = {0.f, 0.f, 0.f, 0.f}, a1 = a0, a2 = a0;
            f32x4 wq[2][16];
#pragma unroll
            for (int e = 0; e < 16; ++e) wq[0][e] = __builtin_nontemporal_load((const f32x4*)(wp + (size_t)e * 12288));
#pragma unroll
            for (int c4 = 0; c4 < 4; ++c4) {
                if (c4 < 3) {
#pragma unroll
                    for (int e = 0; e < 16; ++e) wq[(c4 + 1) & 1][e] = __builtin_nontemporal_load((const f32x4*)(wp + (size_t)(16 * (c4 + 1) + e) * 12288)); }
#pragma unroll
                for (int e = 0; e < 16; ++e) { const int kk = 16 * c4 + e; const f32x4 w = wq[c4 & 1][e];
                    const float s0 = S[k0 + kk], s1 = S[2048 + k0 + kk], s2 = S[4096 + k0 + kk]; a0 += w * s0; a1 += w * s1; a2 += w * s2; }
            }
            *(LAS f32x4*)(red + (wave * 3 + 0) * 256 + lane * 4) = a0; *(LAS f32x4*)(red + (wave * 3 + 1) * 256 + lane * 4) = a1; *(LAS f32x4*)(red + (wave * 3 + 2) * 256 + lane * 4) = a2;
            __syncthreads();
            for (int e = tid; e < 768; e += NTHR) { const int i = e >> 8, col = e & 255; float s = 0.f;
#pragma unroll
                for (int w = 0; w < 8; ++w) s += red[(w * 3 + i) * 256 + col];
                MODP[((size_t)(kg * 4 + l) * 3 + i) * 12288 + cc * 256 + col] = s; }
            __syncthreads();
        }
    }
    {
        const int gtid = blockIdx.x * NTHR + tid, NGT = G * NTHR;
        for (int t = gtid; t < 2 * 131072; t += NGT) {
            const int kv = t >> 17, e = (t & 131071) * 8;
            const int b = e >> 19, j = (e >> 18) & 1, p = (e >> 9) & 511, c = e & 511;
            const float* src = (kv ? a.in[zz + I_CV] : a.in[zz + I_CK]) + e;
            const f32x4 v0 = *(const f32x4*)src, v1 = *(const f32x4*)(src + 4);
            bf16* dst = (bf16*)(ws + (kv ? WS_VS : WS_KS)) + ((size_t)(j * 2 + b) * 2560 + 2048 + p) * 512 + c;
            *(v4u*)dst = pack8(v0, v1);
        }
        if (gtid < 2048) { const int pos = gtid >> 5, p = gtid & 31; const float ang = (float)pos * INV_FREQ[p]; double s, c; sincos_d((double)ang, s, c);
            float* R = (float*)(ws + WS_ROPE); R[gtid] = (float)c; R[2048 + gtid] = (float)s; }
    }
}
__device__ __forceinline__ void ph_modreduce(const Args& a, int zz, int tid, int G) {
    PH_LOCALS;
    const float* MODP = (const float*)(ws + WS_MODP); float* MODF = (float*)(ws + WS_MODF);
    const int gtid = blockIdx.x * NTHR + tid, NGT = G * NTHR;
    for (int e = gtid; e < 4 * 3 * 12288; e += NGT) {
        const int n = e % 12288, li = e / 12288, l = li / 3, q = n >> 11, c = n & 2047;
        float m = a.in[zz + I_BMOD][l * 12288 + n];
#pragma unroll
        for (int kg = 0; kg < 4; ++kg) m += MODP[((size_t)(kg * 4 + l) * 3 + (li - l * 3)) * 12288 + n];
        float v = m;
        if (q == 1) v = a.in[zz + I_GPREMIX][l * 2048 + c] * (1.f + m);
        else if (q == 2) v = a.in[zz + I_GPOSTMIX][l * 2048 + c] * m;
        else if (q == 4) v = a.in[zz + I_GPREFFN][l * 2048 + c] * (1.f + m);
        else if (q == 5) v = a.in[zz + I_GPOSTFFN][l * 2048 + c] * m;
        MODF[(size_t)li * 12288 + n] = v;
    }
}
__device__ __forceinline__ const float* modf_vec(const unsigned char* ws, int l, int idx, int q) { return (const float*)(ws + WS_MODF) + ((size_t)(l * 3 + idx) * 6 + q) * 2048; }
__device__ __forceinline__ void ph_pre0(const Args& a, int zz, int lane, int wave, int G) {
    PH_LOCALS;
    const int gw = blockIdx.x * NWAVES + wave, NGW = G * NWAVES;
    bf16* XN = (bf16*)(ws + WS_XN);
    for (int task = gw; task < M / 4; task += NGW) {
        const int row0 = task * 4, idx = mod_idx(row0);
        const f32x4* Sv = (const f32x4*)modf_vec(ws, 0, idx, 1) + lane; const f32x4* Bv = (const f32x4*)modf_vec(ws, 0, idx, 0) + lane;
        f32x4 S[8], B[8];
#pragma unroll
        for (int j = 0; j < 8; ++j) { S[j] = Sv[64 * j]; B[j] = Bv[64 * j]; }
#pragma unroll 1
        for (int r = 0; r < 4; ++r) {
            const int row = row0 + r;
            const f32x4* xr = (const f32x4*)(row < MP ? a.in[zz + I_XP] + (size_t)row * D : a.in[zz + I_XS] + (size_t)(row - MP) * D) + lane;
            f32x4 v[8]; float ss = 0.f;
#pragma unroll
            for (int j = 0; j < 8; ++j) { v[j] = xr[64 * j]; ss += (v[j].x * v[j].x + v[j].y * v[j].y) + (v[j].z * v[j].z + v[j].w * v[j].w); }
            const float rs = rsqrtf(wave_sum(ss) * (1.f / D) + EPS);
            unsigned long long* o8 = (unsigned long long*)(XN + (size_t)row * D) + lane;
#pragma unroll
            for (int j = 0; j < 8; ++j) o8[64 * j] = pack4(v[j] * rs * S[j] + B[j]);
        }
    }
}
__device__ __forceinline__ void ph_post(const Args& a, int zz, int l, int which, int lane, int wave, int G, bool dry = false) {
    PH_LOCALS;
    float* const xout = dry ? (float*)(ws + WS_DUMMY) : out; (void)xout;
    const int gw = blockIdx.x * NWAVES + wave, NGW = G * NWAVES;
    const bool has_next = (which == 0) || (l < NL - 1);
    const int ln = which == 0 ? l : l + 1, qG = which == 0 ? 2 : 5, qS = which == 0 ? 4 : 1, qB = which == 0 ? 3 : 0;
    const bool first = (l == 0 && which == 0);
    const bool last = (l == NL - 1 && which == 1);
    const bf16* XR = (const bf16*)(ws + WS_XR); bf16* XRo = dry ? (bf16*)(ws + WS_DUMMY) : (bf16*)(ws + WS_XR);
    const bf16* BR = (const bf16*)(ws + WS_BR); bf16* XN = dry ? (bf16*)(ws + WS_DUMMY + 64 * MiB) : (bf16*)(ws + WS_XN);
    for (int task = gw; task < M / 4; task += NGW) {
        const int row0 = task * 4, idx = mod_idx(row0);
        f32x4 Gv[8];
        { const f32x4* p = (const f32x4*)modf_vec(ws, l, idx, qG) + lane;
#pragma unroll
          for (int j = 0; j < 8; ++j) Gv[j] = p[64 * j]; }
        const f32x4* ps = (const f32x4*)modf_vec(ws, has_next ? ln : l, idx, qS) + lane; const f32x4* pb = (const f32x4*)modf_vec(ws, has_next ? ln : l, idx, qB) + lane;
#pragma unroll 1
        for (int rp = 0; rp < 2; ++rp) {
            unsigned long long vr[2][8]; f32x4 x[2][8];
#pragma unroll
            for (int r = 0; r < 2; ++r) {
                const int row = row0 + 2 * rp + r;
                const unsigned long long* br = (const unsigned long long*)(BR + (size_t)row * D) + lane;
#pragma unroll
                for (int j = 0; j < 8; ++j) vr[r][j] = __builtin_nontemporal_load(br + 64 * j);
                if (first) {
                    const f32x4* xr = (const f32x4*)(row < MP ? a.in[zz + I_XP] + (size_t)row * D : a.in[zz + I_XS] + (size_t)(row - MP) * D) + lane;
#pragma unroll
                    for (int j = 0; j < 8; ++j) x[r][j] = __builtin_nontemporal_load(xr + 64 * j);
                } else {
                    const unsigned long long* xr = (const unsigned long long*)(XR + (size_t)row * D) + lane;
#pragma unroll
                    for (int j = 0; j < 8; ++j) { const unsigned long long w = __builtin_nontemporal_load(xr + 64 * j); const unsigned lo = (unsigned)w, hi = (unsigned)(w >> 32);
                        x[r][j].x = __builtin_bit_cast(float, lo << 16); x[r][j].y = __builtin_bit_cast(float, lo & 0xffff0000u); x[r][j].z = __builtin_bit_cast(float, hi << 16); x[r][j].w = __builtin_bit_cast(float, hi & 0xffff0000u); }
                }
            }
#pragma unroll
            for (int r = 0; r < 2; ++r) {
                const int row = row0 + 2 * rp + r;
                f32x4 v[8]; float ss = 0.f;
#pragma unroll
                for (int j = 0; j < 8; ++j) { const unsigned lo = (unsigned)vr[r][j], hi = (unsigned)(vr[r][j] >> 32);
                    v[j].x = __builtin_bit_cast(float, lo << 16); v[j].y = __builtin_bit_cast(float, lo & 0xffff0000u); v[j].z = __builtin_bit_cast(float, hi << 16); v[j].w = __builtin_bit_cast(float, hi & 0xffff0000u);
                    ss += (v[j].x * v[j].x + v[j].y * v[j].y) + (v[j].z * v[j].z + v[j].w * v[j].w); }
                const float rs = rsqrtf(wave_sum(ss) * (1.f / D) + EPS);
                f32x4* xo = (f32x4*)(xout + (size_t)row * D) + lane; unsigned long long* xo16 = (unsigned long long*)(XRo + (size_t)row * D) + lane; float s2 = 0.f;
#pragma unroll
                for (int j = 0; j < 8; ++j) { const f32x4 xn = x[r][j] + Gv[j] * (v[j] * rs); x[r][j] = xn;
                    if (last) __builtin_nontemporal_store(xn, xo + 64 * j); else __builtin_nontemporal_store(pack4(xn), xo16 + 64 * j);
                    s2 += (xn.x * xn.x + xn.y * xn.y) + (xn.z * xn.z + xn.w * xn.w); }
                if (has_next) {
                    const float rs2 = rsqrtf(wave_sum(s2) * (1.f / D) + EPS);
                    unsigned long long* o8 = (unsigned long long*)(XN + (size_t)row * D) + lane;
#pragma unroll
                    for (int j = 0; j < 8; ++j) o8[64 * j] = pack4(x[r][j] * rs2 * ps[64 * j] + pb[64 * j]);
                }
            }
        }
    }
}
__device__ __forceinline__ void ph_qknorm(const Args& a, int zz, int j, int lane, int wave, int G) {
    PH_LOCALS;
    const int gw = blockIdx.x * NWAVES + wave, NGW = G * NWAVES;
    const int hq = lane >> 4, q16 = lane & 15;
    const bf16* QKV = (const bf16*)(ws + WS_QKV); const float* ROPE = (const float*)(ws + WS_ROPE);
    bf16* QB = (bf16*)(ws + WS_QB); bf16* KP = (bf16*)(ws + WS_KP); bf16* VP = (bf16*)(ws + WS_VP);
    bf16* KSj = (bf16*)(ws + WS_KS) + (size_t)j * 2 * 2560 * 512; bf16* VSj = (bf16*)(ws + WS_VS) + (size_t)j * 2 * 2560 * 512;
    const f32x4 gq0 = *(const f32x4*)(a.in[zz + I_GQ] + j * 128 + q16 * 8), gq1 = *(const f32x4*)(a.in[zz + I_GQ] + j * 128 + q16 * 8 + 4);
    const f32x4 gk0 = *(const f32x4*)(a.in[zz + I_GK] + j * 128 + q16 * 8), gk1 = *(const f32x4*)(a.in[zz + I_GK] + j * 128 + q16 * 8 + 4);
    const float sgn = (q16 & 4) ? 1.f : -1.f;
    for (int row = gw; row < M; row += NGW) {
        const bool samp = row >= MP; const int b = samp ? (row - MP) >> 11 : row >> 8, t = samp ? (row - MP) & 2047 : row & 255;
        f32x4 c0 = {1.f, 1.f, 1.f, 1.f}, c1 = c0, s0 = {0.f, 0.f, 0.f, 0.f}, s1 = s0;
        if (samp) { const int pos = (q16 < 8) ? (t >> 6) : (t & 63); const float* rp = ROPE + pos * 32 + 8 * (q16 & 3);
            c0 = *(const f32x4*)rp; c1 = *(const f32x4*)(rp + 4); s0 = *(const f32x4*)(rp + 2048); s1 = *(const f32x4*)(rp + 2052); }
#pragma unroll
        for (int it = 0; it < 6; ++it) {
            const v4u raw = *(const v4u*)(QKV + (size_t)row * NQKV + it * 512 + hq * 128 + q16 * 8);
            f32x4 v0, v1; v0.x = __builtin_bit_cast(float, raw.x << 16); v0.y = __builtin_bit_cast(float, raw.x & 0xffff0000u); v0.z = __builtin_bit_cast(float, raw.y << 16); v0.w = __builtin_bit_cast(float, raw.y & 0xffff0000u);
            v1.x = __builtin_bit_cast(float, raw.z << 16); v1.y = __builtin_bit_cast(float, raw.z & 0xffff0000u); v1.z = __builtin_bit_cast(float, raw.w << 16); v1.w = __builtin_bit_cast(float, raw.w & 0xffff0000u);
            if (it < 5) {
                float ss = (v0.x * v0.x + v0.y * v0.y) + (v0.z * v0.z + v0.w * v0.w) + (v1.x * v1.x + v1.y * v1.y) + (v1.z * v1.z + v1.w * v1.w);
                ss += __shfl_xor(ss, 1); ss += __shfl_xor(ss, 2); ss += __shfl_xor(ss, 4); ss += __shfl_xor(ss, 8);
                const float rs = rsqrtf(ss * (1.f / 128.f) + EPS);
                v0 = v0 * rs * (it < 4 ? gq0 : gk0); v1 = v1 * rs * (it < 4 ? gq1 : gk1);
                if (samp) {
                    f32x4 p0, p1;
                    p0.x = __shfl_xor(v0.x, 4); p0.y = __shfl_xor(v0.y, 4); p0.z = __shfl_xor(v0.z, 4); p0.w = __shfl_xor(v0.w, 4);
                    p1.x = __shfl_xor(v1.x, 4); p1.y = __shfl_xor(v1.y, 4); p1.z = __shfl_xor(v1.z, 4); p1.w = __shfl_xor(v1.w, 4);
                    v0 = v0 * c0 + (p0 * s0) * sgn; v1 = v1 * c1 + (p1 * s1) * sgn;
                }
            }
            const v4u pk = pack8(v0, v1);
            if (it < 4) *(v4u*)(QB + (size_t)row * D + it * 512 + hq * 128 + q16 * 8) = pk;
            else {
                bf16* dstS = (it == 4 ? KSj : VSj) + ((size_t)b * 2560 + t) * 512 + hq * 128 + q16 * 8;
                bf16* dstP = (it == 4 ? KP : VP) + (size_t)row * 512 + hq * 128 + q16 * 8;
                if (samp) *(v4u*)dstS = pk;
                else { *(v4u*)dstP = pk; float* o = out + (it == 4 ? OUT_CK : OUT_CV) + ((size_t)(b * 2 + j) * 256 + t) * 512 + hq * 128 + q16 * 8; __builtin_nontemporal_store(v0, (f32x4*)o); __builtin_nontemporal_store(v1, (f32x4*)(o + 4)); }
            }
        }
    }
}

__device__ __forceinline__ float rg_coef(float lam) {
    const float x = __expf(-lam);
    const float l1p = (x < 0.05f) ? x * (1.f + x * (-0.5f + x * (0.33333333f + x * (-0.25f + x * (0.2f + x * (-0.16666667f)))))) : __logf(1.f + x);
    return -8.0f * l1p;
}
__device__ __forceinline__ void rg_elem(float racc, float iacc, float coef, float xc, float& a, float& u) {
    const float r = sigmoid_f(racc), ig = sigmoid_f(iacc), la = coef * r;
    a = __builtin_amdgcn_exp2f(1.4426950408889634f * la);
    const float z = 2.f * la;
    const float poly = -z * (1.f + z * (0.5f + z * (0.16666667f + z * (0.041666668f + z * 0.0083333338f)))), big = 1.f - a * a;
    const float sel = (z > -0.1f) ? 1.f : 0.f; const float m1 = big + sel * (poly - big);
    u = __builtin_amdgcn_sqrtf(m1) * ig * xc;
}
__device__ __forceinline__ void seq_bounds(int row, int& s0, int& T) { if (row < MP) { s0 = row & ~255; T = 256; } else { s0 = MP + ((row - MP) & ~2047); T = 2048; } }

#if MK_NAIVE_RG
__device__ __forceinline__ void ph_rg_conv_naive(const Args& a, int zz, int jl, int tid, int G) {
    PH_LOCALS;
    const int gtid = blockIdx.x * NTHR + tid, NGT = G * NTHR;
    const bf16* XB = (const bf16*)(ws + WS_XB); float* XC = (float*)(ws + WS_NXC);
    const float* cw = a.in[zz + I_CONVW] + (size_t)jl * 4 * 2048; const float* cb = a.in[zz + I_CONVB] + (size_t)jl * 2048;
    for (int task = gtid; task < M * 512; task += NGT) {
        const int row = task >> 9, c4 = (task & 511) * 4; int s0, T; seq_bounds(row, s0, T);
        f32x4 acc = *(const f32x4*)(cb + c4);
#pragma unroll
        for (int k = 0; k < 4; ++k) { const int r2 = row + k - 1; if (r2 >= s0 && r2 < s0 + T) { const unsigned long long xv = *(const unsigned long long*)(XB + (size_t)r2 * 2048 + c4); const unsigned lo = (unsigned)xv, hi = (unsigned)(xv >> 32); f32x4 xf; xf.x = __builtin_bit_cast(float, lo << 16); xf.y = __builtin_bit_cast(float, lo & 0xffff0000u); xf.z = __builtin_bit_cast(float, hi << 16); xf.w = __builtin_bit_cast(float, hi & 0xffff0000u); acc += *(const f32x4*)(cw + k * 2048 + c4) * xf; } }
        *(f32x4*)(XC + (size_t)row * 2048 + c4) = acc;
    }
}
__device__ __forceinline__ void ph_rg_gates_naive(const Args& a, int zz, int jl, int tid, int G) {
    PH_LOCALS;
    const int gtid = blockIdx.x * NTHR + tid, NGT = G * NTHR;
    const float* XC = (const float*)(ws + WS_NXC);
    float* AF = (float*)(ws + WS_NAF); float* UF = (float*)(ws + WS_NUF); float* AB = (float*)(ws + WS_NAB); float* UB = (float*)(ws + WS_NUB);
    for (int task = gtid; task < M * 2048; task += NGT) {
        const int row = task >> 11, ch = task & 2047, n = ch >> 7, k = ch & 127;
        const float* xc = XC + (size_t)row * 2048 + n * 128;
        const float* wa0 = a.in[zz + I_WRGA] + ((size_t)((jl * 2 + 0) * 16 + n) * 128) * 128 + k; const float* wa1 = a.in[zz + I_WRGA] + ((size_t)((jl * 2 + 1) * 16 + n) * 128) * 128 + k;
        const float* wx0 = a.in[zz + I_WRGX] + ((size_t)((jl * 2 + 0) * 16 + n) * 128) * 128 + k; const float* wx1 = a.in[zz + I_WRGX] + ((size_t)((jl * 2 + 1) * 16 + n) * 128) * 128 + k;
        float r0 = 0.f, r1 = 0.f, i0 = 0.f, i1 = 0.f;
#pragma unroll 8
        for (int j = 0; j < 128; ++j) { const float x = xc[j]; r0 += x * wa0[j * 128]; r1 += x * wa1[j * 128]; i0 += x * wx0[j * 128]; i1 += x * wx1[j * 128]; }
        const float xv = xc[k];
        float av, uv;
        rg_elem(r0 + a.in[zz + I_BRGA][(jl * 2 + 0) * 2048 + ch], i0 + a.in[zz + I_BRGX][(jl * 2 + 0) * 2048 + ch], rg_coef(a.in[zz + I_LAM][(jl * 2 + 0) * 2048 + ch]), xv, av, uv);
        AF[task] = av; UF[task] = uv;
        rg_elem(r1 + a.in[zz + I_BRGA][(jl * 2 + 1) * 2048 + ch], i1 + a.in[zz + I_BRGX][(jl * 2 + 1) * 2048 + ch], rg_coef(a.in[zz + I_LAM][(jl * 2 + 1) * 2048 + ch]), xv, av, uv);
        AB[task] = av; UB[task] = uv;
    }
}
__device__ __forceinline__ void ph_rg_scan_naive(const Args& a, int zz, int jl, int tid, int G) {
    PH_LOCALS;
    const int gtid = blockIdx.x * NTHR + tid, NGT = G * NTHR;
    for (int task = gtid; task < 18 * 2 * 2048; task += NGT) {
        const int sq = task >> 12, dir = (task >> 11) & 1, ch = task & 2047;
        int row0, T; float h;
        if (sq < 16) { row0 = sq * 256; T = 256; h = 0.f; } else { row0 = MP + (sq - 16) * 2048; T = 2048; h = a.in[zz + I_STATE][((size_t)((sq - 16) * 2 + jl) * 2 + dir) * 2048 + ch]; }
        const float* A = (const float*)(ws + (dir ? WS_NAB : WS_NAF)); float* U = (float*)(ws + (dir ? WS_NUB : WS_NUF));
        for (int tt = 0; tt < T; tt += 8) {
            float av[8], uv[8];
#pragma unroll
            for (int e = 0; e < 8; ++e) { const int t = dir ? (T - 1 - tt - e) : (tt + e); av[e] = A[(size_t)(row0 + t) * 2048 + ch]; uv[e] = U[(size_t)(row0 + t) * 2048 + ch]; }
#pragma unroll
            for (int e = 0; e < 8; ++e) { const int t = dir ? (T - 1 - tt - e) : (tt + e); h = av[e] * h + uv[e]; U[(size_t)(row0 + t) * 2048 + ch] = h; }
        }
        if (sq < 16) out[OUT_ST + ((size_t)(sq * 2 + jl) * 2 + dir) * 2048 + ch] = h;
    }
}
__device__ __forceinline__ void ph_rg_y_naive(const Args& a, int zz, int tid, int G) {
    PH_LOCALS;
    const int gtid = blockIdx.x * NTHR + tid, NGT = G * NTHR;
    const float* UF = (const float*)(ws + WS_NUF); const float* UB = (const float*)(ws + WS_NUB); const bf16* GT = (const bf16*)(ws + WS_GATE); bf16* MIX = (bf16*)(ws + WS_MIX);
    for (int task = gtid; task < M * 2048 / 8; task += NGT) {
        const size_t e = (size_t)task * 8;
        const f32x4 f0 = *(const f32x4*)(UF + e), f1 = *(const f32x4*)(UF + e + 4), b0 = *(const f32x4*)(UB + e), b1 = *(const f32x4*)(UB + e + 4);
        const v4u g = *(const v4u*)(GT + e);
        f32x4 g0, g1; g0.x = __builtin_bit_cast(float, g.x << 16); g0.y = __builtin_bit_cast(float, g.x & 0xffff0000u); g0.z = __builtin_bit_cast(float, g.y << 16); g0.w = __builtin_bit_cast(float, g.y & 0xffff0000u);
        g1.x = __builtin_bit_cast(float, g.z << 16); g1.y = __builtin_bit_cast(float, g.z & 0xffff0000u); g1.z = __builtin_bit_cast(float, g.w << 16); g1.w = __builtin_bit_cast(float, g.w & 0xffff0000u);
        *(v4u*)(MIX + e) = pack8((f0 + b0) * g0, (f1 + b1) * g1);
    }
}
#endif

#if MK_NAIVE_ATTN
__device__ __forceinline__ void ph_attn_naive(const Args& a, int zz, int j, int tid, int G) {
    PH_LOCALS;
    const int gtid = blockIdx.x * NTHR + tid, NGT = G * NTHR;
    const bf16* QB = (const bf16*)(ws + WS_QB); bf16* OB = (bf16*)(ws + WS_MIX);
    const bf16* KP = (const bf16*)(ws + WS_KP); const bf16* VP = (const bf16*)(ws + WS_VP);
    const bf16* KSj = (const bf16*)(ws + WS_KS) + (size_t)j * 2 * 2560 * 512; const bf16* VSj = (const bf16*)(ws + WS_VS) + (size_t)j * 2 * 2560 * 512;
    constexpr float C = 0.088388347648318440f * 1.4426950408889634f;
    for (int lt = gtid; lt < M * 64; lt += NGT) {
        const int sub = lt & 3, h = (lt >> 2) & 15, row = lt >> 6, kvh = h >> 2;
        const bf16* Kb; const bf16* Vb; int nk;
        if (row < MP) { const int b = row >> 8; Kb = KP + (size_t)(b * 256) * 512 + kvh * 128 + sub * 32; Vb = VP + (size_t)(b * 256) * 512 + kvh * 128 + sub * 32; nk = 256; }
        else { const int b = (row - MP) >> 11; Kb = KSj + (size_t)(b * 2560) * 512 + kvh * 128 + sub * 32; Vb = VSj + (size_t)(b * 2560) * 512 + kvh * 128 + sub * 32; nk = 2560; }
        float q[32], o[32];
        { const bf16* qp = QB + (size_t)row * D + h * 128 + sub * 32;
#pragma unroll
          for (int d = 0; d < 32; ++d) { q[d] = bf2f(qp[d]) * C; o[d] = 0.f; } }
        float m = -1e30f, l = 0.f;
        for (int kk = 0; kk < nk; ++kk) {
            const v4u* kp = (const v4u*)(Kb + (size_t)kk * 512); const v4u* vp = (const v4u*)(Vb + (size_t)kk * 512);
            float s = 0.f;
#pragma unroll
            for (int c = 0; c < 4; ++c) { const v4u w = kp[c];
                s += q[8 * c + 0] * __builtin_bit_cast(float, w.x << 16) + q[8 * c + 1] * __builtin_bit_cast(float, w.x & 0xffff0000u) + q[8 * c + 2] * __builtin_bit_cast(float, w.y << 16) + q[8 * c + 3] * __builtin_bit_cast(float, w.y & 0xffff0000u)
                   + q[8 * c + 4] * __builtin_bit_cast(float, w.z << 16) + q[8 * c + 5] * __builtin_bit_cast(float, w.z & 0xffff0000u) + q[8 * c + 6] * __builtin_bit_cast(float, w.w << 16) + q[8 * c + 7] * __builtin_bit_cast(float, w.w & 0xffff0000u); }
            s += __shfl_xor(s, 1); s += __shfl_xor(s, 2);
            const float mn = fmaxf(m, s), al = __builtin_amdgcn_exp2f(m - mn), p = __builtin_amdgcn_exp2f(s - mn);
            l = l * al + p; m = mn;
#pragma unroll
            for (int c = 0; c < 4; ++c) { const v4u w = vp[c];
                o[8 * c + 0] = o[8 * c + 0] * al + p * __builtin_bit_cast(float, w.x << 16); o[8 * c + 1] = o[8 * c + 1] * al + p * __builtin_bit_cast(float, w.x & 0xffff0000u);
                o[8 * c + 2] = o[8 * c + 2] * al + p * __builtin_bit_cast(float, w.y << 16); o[8 * c + 3] = o[8 * c + 3] * al + p * __builtin_bit_cast(float, w.y & 0xffff0000u);
                o[8 * c + 4] = o[8 * c + 4] * al + p * __builtin_bit_cast(float, w.z << 16); o[8 * c + 5] = o[8 * c + 5] * al + p * __builtin_bit_cast(float, w.z & 0xffff0000u);
                o[8 * c + 6] = o[8 * c + 6] * al + p * __builtin_bit_cast(float, w.w << 16); o[8 * c + 7] = o[8 * c + 7] * al + p * __builtin_bit_cast(float, w.w & 0xffff0000u); }
        }
        const float il = 1.f / l;
        bf16* op = OB + (size_t)row * D + h * 128 + sub * 32;
#pragma unroll
        for (int c = 0; c < 4; ++c) { f32x4 x0 = {o[8 * c] * il, o[8 * c + 1] * il, o[8 * c + 2] * il, o[8 * c + 3] * il}, x1 = {o[8 * c + 4] * il, o[8 * c + 5] * il, o[8 * c + 6] * il, o[8 * c + 7] * il}; *(v4u*)(op + 8 * c) = pack8(x0, x1); }
    }
}
#endif
namespace attn_body {
using bf16 = __hip_bfloat16;
constexpr int   D = 128, NW = 8, QBLK = 32, KVBLK = 64;
constexpr float SCALE = 0.088388347648318440f;
constexpr float THR = 8.f;
constexpr int SDEPTH = 2;
constexpr int LDQ = 2048, LDK = 512, LDO = 2048;
constexpr size_t SHM_V = KVBLK * D * 2, SHM_K = KVBLK * D * 2, SHM_ATTN = 2 * SHM_V + 2 * SHM_K + NW * 64 * 4;
using bf16x8 = __attribute__((ext_vector_type(8))) short;
using s16x4  = __attribute__((ext_vector_type(4))) short;
using f32x16 = __attribute__((ext_vector_type(16))) float;
using f32x8  = __attribute__((ext_vector_type(8))) float;
using u32x4  = __attribute__((ext_vector_type(4))) unsigned;
#define KSWZ(row, colB) ((row) * 256 + ((colB) ^ (((row) & 7) << 4)))
#define SBAR() __builtin_amdgcn_sched_barrier(0)
__device__ __forceinline__ int crow(int r, int hi) { return (r & 3) + 8 * (r >> 2) + 4 * hi; }
__device__ __forceinline__ unsigned cvtpk(float lo, float hi) {
  unsigned r; asm volatile("v_cvt_pk_bf16_f32 %0, %1, %2" : "=v"(r) : "v"(lo), "v"(hi)); return r;
}
template <typename TIn> struct Stage;
template <> struct Stage<bf16>  { using T = bf16x8;
  __device__ static __forceinline__ T ld8(const bf16* p) { return *reinterpret_cast<const bf16x8*>(p); }
  __device__ static __forceinline__ bf16x8 tobf(T x) { return x; } };
template <> struct Stage<float> { using T = f32x8;
  __device__ static __forceinline__ T ld8(const float* p) { return *reinterpret_cast<const f32x8*>(p); }
  __device__ static __forceinline__ bf16x8 tobf(T x) {
    u32x4 w = {cvtpk(x[0], x[1]), cvtpk(x[2], x[3]), cvtpk(x[4], x[5]), cvtpk(x[6], x[7])}; return *reinterpret_cast<bf16x8*>(&w); } };

__device__ __forceinline__ void partialSM(f32x16& p0, f32x16& p1, float& m_reg, float& mn, float& alpha) {
  constexpr float C = SCALE * 1.4426950408889634f;
  float pmax = p0[0]; for (int r = 1; r < 16; ++r) pmax = fmaxf(pmax, p0[r]); for (int r = 0; r < 16; ++r) pmax = fmaxf(pmax, p1[r]);
  { auto rr = __builtin_amdgcn_permlane32_swap(__float_as_uint(pmax), __float_as_uint(pmax), false, false);
    pmax = fmaxf(__uint_as_float(rr[0]), __uint_as_float(rr[1])); }
  if (__builtin_expect(__all(pmax - m_reg <= THR / SCALE), 1)) { mn = m_reg; alpha = 1.f; }
  else { mn = fmaxf(m_reg, pmax); alpha = __builtin_amdgcn_exp2f((m_reg - mn) * C); m_reg = mn; }
  float mnC = -mn * C;
  for (int r = 0; r < 16; ++r) p0[r] = fmaf(p0[r], C, mnC); for (int r = 0; r < 16; ++r) p1[r] = fmaf(p1[r], C, mnC);
  for (int r = 0; r < 16; ++r) p0[r] = __builtin_amdgcn_exp2f(p0[r]);
}
__device__ __forceinline__ void finishSM(f32x16& p0, f32x16& p1, float alpha, float& l_reg, bf16x8& pa0, bf16x8& pa1, bf16x8& pa2, bf16x8& pa3) {
  for (int r = 0; r < 16; ++r) p1[r] = __builtin_amdgcn_exp2f(p1[r]);
  float ps = 0; for (int r = 0; r < 16; ++r) ps += p0[r]; for (int r = 0; r < 16; ++r) ps += p1[r];
  { auto rr = __builtin_amdgcn_permlane32_swap(__float_as_uint(ps), __float_as_uint(ps), false, false);
    ps = __uint_as_float(rr[0]) + __uint_as_float(rr[1]); }
  l_reg = l_reg * alpha + ps;
#define PK4(P, BASE, OUT) do { unsigned a0 = cvtpk(P[BASE + 0], P[BASE + 1]), a1 = cvtpk(P[BASE + 2], P[BASE + 3]);   \
    unsigned b0 = cvtpk(P[BASE + 4], P[BASE + 5]), b1 = cvtpk(P[BASE + 6], P[BASE + 7]);                              \
    auto r0 = __builtin_amdgcn_permlane32_swap(a0, b0, false, false); auto r1 = __builtin_amdgcn_permlane32_swap(a1, b1, false, false); \
    u32x4 w = {r0[0], r1[0], r0[1], r1[1]}; OUT = *reinterpret_cast<bf16x8*>(&w); } while (0)
  PK4(p0, 0, pa0); PK4(p0, 8, pa1); PK4(p1, 0, pa2); PK4(p1, 8, pa3);
#undef PK4
}
__device__ __forceinline__ void qkt(f32x16& p0, f32x16& p1, const bf16* Ks, const bf16x8* qr, int r32, int hi) {
  p0 = f32x16{}; p1 = f32x16{};
  for (int d0 = 0; d0 < 8; ++d0) { int cb = (d0 * 16 + hi * 8) * 2;
    bf16x8 b0 = *reinterpret_cast<const bf16x8*>((const char*)Ks + KSWZ(r32, cb));
    bf16x8 b1 = *reinterpret_cast<const bf16x8*>((const char*)Ks + KSWZ(32 + r32, cb));
    p0 = __builtin_amdgcn_mfma_f32_32x32x16_bf16(b0, qr[d0], p0, 0, 0, 0);
    p1 = __builtin_amdgcn_mfma_f32_32x32x16_bf16(b1, qr[d0], p1, 0, 0, 0); }
}
__device__ __forceinline__ int v_st(int k, int c) { const int kk = (k & ~0xC) | ((k & 4) << 1) | ((k & 8) >> 1); return ((kk >> 3) * 4 + (c >> 5)) * 512 + ((kk & 7) * 32 + (c & 31)) * 2; }
__device__ __forceinline__ int v_rd_base(int lane) { return ((lane & 3) << 3) | (((lane >> 2) & 3) << 6) | (((lane >> 4) & 1) << 5) | (((lane >> 5) & 1) << 8); }
constexpr int v_rd_off(int d0, int ks, int half) { return d0 * 512 + ks * 4096 + half * 2048; }
template <int OFF> __device__ __forceinline__ s16x4 tr_read(int vb) {
  s16x4 r; asm volatile("ds_read_b64_tr_b16 %0, %1 offset:%2" : "=&v"(r) : "v"(vb), "i"(OFF) : "memory"); return r;
}
template <int D0> __device__ __forceinline__ void pv_one(f32x16& od, int vb, bf16x8 pa0, bf16x8 pa1, bf16x8 pa2, bf16x8 pa3) {
  const s16x4 l0 = tr_read<v_rd_off(D0, 0, 0)>(vb), h0 = tr_read<v_rd_off(D0, 0, 1)>(vb), l1 = tr_read<v_rd_off(D0, 1, 0)>(vb), h1 = tr_read<v_rd_off(D0, 1, 1)>(vb);
  const s16x4 l2 = tr_read<v_rd_off(D0, 2, 0)>(vb), h2 = tr_read<v_rd_off(D0, 2, 1)>(vb), l3 = tr_read<v_rd_off(D0, 3, 0)>(vb), h3 = tr_read<v_rd_off(D0, 3, 1)>(vb);
  asm volatile("s_waitcnt lgkmcnt(0)" ::: "memory"); SBAR();
#define PK(L, H) (bf16x8){L[0], L[1], L[2], L[3], H[0], H[1], H[2], H[3]}
  od = __builtin_amdgcn_mfma_f32_32x32x16_bf16(pa0, PK(l0, h0), od, 0, 0, 0);
  od = __builtin_amdgcn_mfma_f32_32x32x16_bf16(pa1, PK(l1, h1), od, 0, 0, 0);
  od = __builtin_amdgcn_mfma_f32_32x32x16_bf16(pa2, PK(l2, h2), od, 0, 0, 0);
  od = __builtin_amdgcn_mfma_f32_32x32x16_bf16(pa3, PK(l3, h3), od, 0, 0, 0);
#undef PK
}
__device__ __forceinline__ void pv_d0(f32x16* o, int vb, bf16x8 pa0, bf16x8 pa1, bf16x8 pa2, bf16x8 pa3) {
  pv_one<0>(o[0], vb, pa0, pa1, pa2, pa3); pv_one<1>(o[1], vb, pa0, pa1, pa2, pa3); pv_one<2>(o[2], vb, pa0, pa1, pa2, pa3); pv_one<3>(o[3], vb, pa0, pa1, pa2, pa3);
}
template <typename TQ>
__device__ __forceinline__ void attn_dense_body(const TQ* __restrict__ Qb, const bf16* __restrict__ Kh, const bf16* __restrict__ Vh,
                                                bf16* __restrict__ Ob, int seq, char* lds, int tid) {
  using St = Stage<bf16>; using SQ = Stage<TQ>;
  const int wid = tid >> 6, lane = tid & 63, r32 = lane & 31, hi = lane >> 5;
  bf16* V_lds = (bf16*)lds; bf16* K_lds = (bf16*)(lds + 2 * SHM_V);
  float* ws = (float*)(lds + 2 * SHM_V + 2 * SHM_K) + wid * 64; float* li_l = ws; float* al_l = ws + 32;
  float m_reg = -1e30f, l_reg = 0; f32x16 o[4] = {}; bf16x8 qr[8];
  const TQ* Qw = Qb + (long)(wid * QBLK + r32) * LDQ + hi * 8;
#pragma unroll
  for (int d0 = 0; d0 < 8; ++d0) qr[d0] = SQ::tobf(SQ::ld8(Qw + d0 * 16));
  const int sr = tid >> 4, sc = (tid & 15) * 8, vst0 = v_st(sr, sc), vst1 = v_st(32 + sr, sc);
  const int vb0 = (int)(uintptr_t)V_lds + v_rd_base(lane);
  struct { typename St::T vs0, vs1, ks0, ks1; } sr_[SDEPTH];
#define SLOAD(i, k0) do { sr_[i].vs0 = St::ld8(&Vh[(long)((k0) + sr) * LDK + sc]); sr_[i].vs1 = St::ld8(&Vh[(long)((k0) + 32 + sr) * LDK + sc]); \
    sr_[i].ks0 = St::ld8(&Kh[(long)((k0) + sr) * LDK + sc]); sr_[i].ks1 = St::ld8(&Kh[(long)((k0) + 32 + sr) * LDK + sc]); } while (0)
#define SWRITE(b, i) do { *(bf16x8*)((char*)V_lds + (b) * SHM_V + vst0) = St::tobf(sr_[i].vs0);          \
    *(bf16x8*)((char*)V_lds + (b) * SHM_V + vst1) = St::tobf(sr_[i].vs1); int kc = sc * 2;               \
    *(bf16x8*)((char*)K_lds + (b) * SHM_K + KSWZ(sr, kc)) = St::tobf(sr_[i].ks0);                       \
    *(bf16x8*)((char*)K_lds + (b) * SHM_K + KSWZ(32 + sr, kc)) = St::tobf(sr_[i].ks1); } while (0)
#define SWAIT() do { if constexpr (SDEPTH == 2) asm volatile("s_waitcnt vmcnt(4)" ::: "memory"); else asm volatile("s_waitcnt vmcnt(0)" ::: "memory"); } while (0)
#define RESC(a) do { if (__any((a) < 1.f)) { if (hi == 0) al_l[r32] = (a); asm volatile("s_waitcnt lgkmcnt(0)" ::: "memory"); \
    for (int d = 0; d < 4; ++d) for (int r = 0; r < 16; ++r) o[d][r] *= al_l[crow(r, hi)]; } } while (0)
  f32x16 pA0, pA1, pB0, pB1; float mnA, mnB, alA, alB; bf16x8 pa0, pa1, pa2, pa3; const int NT = seq / KVBLK;
  constexpr int SE = 0, SO = SDEPTH - 1;
  SLOAD(SE, 0); asm volatile("s_waitcnt vmcnt(0)" ::: "memory"); SWRITE(0, SE); __syncthreads();
  qkt(pA0, pA1, K_lds, qr, r32, hi); partialSM(pA0, pA1, m_reg, mnA, alA);
  SLOAD(SO, KVBLK); SLOAD(SE, 2 * KVBLK);
  SWAIT(); SWRITE(1, SO); __syncthreads();
  for (int j = 1; j + 1 < NT; j += 2) {
    SBAR(); qkt(pB0, pB1, (bf16*)((char*)K_lds + SHM_K), qr, r32, hi);
    finishSM(pA0, pA1, alA, l_reg, pa0, pa1, pa2, pa3); SBAR();
    SLOAD(SO, (j + SDEPTH) * KVBLK); SBAR();
    pv_d0(o, vb0, pa0, pa1, pa2, pa3); partialSM(pB0, pB1, m_reg, mnB, alB);
    __syncthreads(); SWAIT(); SWRITE(0, SE);
    RESC(alB); __syncthreads();
    SBAR(); qkt(pA0, pA1, K_lds, qr, r32, hi);
    finishSM(pB0, pB1, alB, l_reg, pa0, pa1, pa2, pa3); SBAR();
    SLOAD(SE, (j + 3 < NT ? j + 3 : NT - 1) * KVBLK); SBAR();
    pv_d0(o, vb0 + (int)SHM_V, pa0, pa1, pa2, pa3); partialSM(pA0, pA1, m_reg, mnA, alA);
    __syncthreads(); SWAIT(); SWRITE(1, SO);
    RESC(alA); __syncthreads();
  }
  SBAR(); qkt(pB0, pB1, (bf16*)((char*)K_lds + SHM_K), qr, r32, hi);
  finishSM(pA0, pA1, alA, l_reg, pa0, pa1, pa2, pa3); SBAR();
  pv_d0(o, vb0, pa0, pa1, pa2, pa3); partialSM(pB0, pB1, m_reg, mnB, alB);
  __syncthreads(); RESC(alB);
  finishSM(pB0, pB1, alB, l_reg, pa0, pa1, pa2, pa3); SBAR();
  pv_d0(o, vb0 + (int)SHM_V, pa0, pa1, pa2, pa3);
  int lane_e = lane; asm volatile("" : "+v"(lane_e)); const int r32e = lane_e & 31, hie = lane_e >> 5;
  if (hie == 0) li_l[r32e] = l_reg; asm volatile("s_waitcnt lgkmcnt(0)" ::: "memory");
  float rli[16];
#pragma unroll
  for (int r = 0; r < 16; ++r) rli[r] = __builtin_amdgcn_rcpf(li_l[crow(r, hie)]);
  unsigned short* ost = (unsigned short*)(lds + SHM_ATTN) + wid * (QBLK * D);
#pragma unroll
  for (int r = 0; r < 16; ++r) { const int orow = crow(r, hie);
#pragma unroll
    for (int d0 = 0; d0 < 4; ++d0) ost[orow * D + d0 * 32 + r32e] = (unsigned short)(cvtpk(o[d0][r] * rli[r], 0.f) & 0xffffu); }
  asm volatile("s_waitcnt lgkmcnt(0)" ::: "memory");
  bf16* Ow = Ob + (long)(wid * QBLK) * LDO;
#pragma unroll
  for (int it = 0; it < 8; ++it) { const int orow = it * 4 + (lane_e >> 4), ch = lane_e & 15;
    const u32x4 v = *reinterpret_cast<const u32x4*>(ost + orow * D + ch * 8);
    *reinterpret_cast<u32x4*>(Ow + (long)orow * LDO + ch * 8) = v; }
#undef SLOAD
#undef SWRITE
#undef SWAIT
#undef RESC
}
constexpr size_t SHM_TOTAL = SHM_ATTN + (size_t)NW * QBLK * D * 2;
}
__device__ __forceinline__ void ph_attn(const Args& a, int zz, int j, unsigned char* lds_raw, int tid, int G) {
    PH_LOCALS;
    const attn_body::bf16* QB = (const attn_body::bf16*)(ws + WS_QB); attn_body::bf16* OB = (attn_body::bf16*)(ws + WS_MIX);
    const attn_body::bf16* KP = (const attn_body::bf16*)(ws + WS_KP); const attn_body::bf16* VP = (const attn_body::bf16*)(ws + WS_VP);
    const attn_body::bf16* KSj = (const attn_body::bf16*)(ws + WS_KS) + (size_t)j * 2 * 2560 * 512; const attn_body::bf16* VSj = (const attn_body::bf16*)(ws + WS_VS) + (size_t)j * 2 * 2560 * 512;
    const int bx = blockIdx.x, vcu = (G % 8 == 0) ? (bx % 8) * (G / 8) + bx / 8 : bx;
#pragma unroll 1
    for (int u = vcu; u < 512; u += G) {
        size_t qoff, koff; int seq; const attn_body::bf16* Kb; const attn_body::bf16* Vb;
        if (u < 256) { const int b = u >> 7, rem = u & 127, h = rem >> 3, qb = rem & 7; qoff = (size_t)(MP + b * 2048 + qb * 256) * D + h * 128; koff = (size_t)(b * 2560) * 512 + (h >> 2) * 128; seq = 2560; Kb = KSj; Vb = VSj; }
        else { const int pu = u - 256, b = pu >> 4, h = pu & 15; qoff = (size_t)(b * 256) * D + h * 128; koff = (size_t)(b * 256) * 512 + (h >> 2) * 128; seq = 256; Kb = KP; Vb = VP; }
        int tid_u = tid; asm volatile("" : "+v"(tid_u));
        attn_body::attn_dense_body<attn_body::bf16>(QB + qoff, Kb + koff, Vb + koff, OB + qoff, seq, (char*)lds_raw, tid_u);
    }
}

constexpr int RG_AIMG = 0, RG_BIMG = 65536, RG_STG = 98304, RG_SUM = 131072;
__device__ __forceinline__ int swz16(int row, int colB) { return row * 256 + (colB ^ ((row & 15) << 4)); }
typedef float f32x16 __attribute__((ext_vector_type(16)));
typedef float f32x2v __attribute__((ext_vector_type(2)));
__device__ __forceinline__ int crow16(int q, int hh) { return (q & 3) + 8 * (q >> 2) + 4 * hh; }

template <bool REV> __device__ __forceinline__ void rg_scan_tile(float (&a)[16], float (&u)[16], const bool hi, float& TA, float& TB) {
    float GA[4], GB[4];
#pragma unroll
    for (int g = 0; g < 4; ++g) {
        if (!REV) {
#pragma unroll
            for (int i = 1; i < 4; ++i) { u[4 * g + i] = a[4 * g + i] * u[4 * g + i - 1] + u[4 * g + i]; a[4 * g + i] = a[4 * g + i] * a[4 * g + i - 1]; }
            GA[g] = a[4 * g + 3]; GB[g] = u[4 * g + 3];
        } else {
#pragma unroll
            for (int i = 2; i >= 0; --i) { u[4 * g + i] = a[4 * g + i] * u[4 * g + i + 1] + u[4 * g + i]; a[4 * g + i] = a[4 * g + i] * a[4 * g + i + 1]; }
            GA[g] = a[4 * g]; GB[g] = u[4 * g];
        }
    }
    float EA[8], EB[8];
#pragma unroll
    for (int g = 0; g < 4; ++g) {
        const auto ra = __builtin_amdgcn_permlane32_swap(__float_as_uint(GA[g]), __float_as_uint(GA[g]), false, false);
        const auto rb = __builtin_amdgcn_permlane32_swap(__float_as_uint(GB[g]), __float_as_uint(GB[g]), false, false);
        EA[2 * g] = __uint_as_float(ra[0]); EA[2 * g + 1] = __uint_as_float(ra[1]); EB[2 * g] = __uint_as_float(rb[0]); EB[2 * g + 1] = __uint_as_float(rb[1]);
    }
    float PA = 1.f, PB = 0.f, preA[8], preB[8];
#pragma unroll
    for (int k = 0; k < 8; ++k) { const int Gi = REV ? 7 - k : k; preA[Gi] = PA; preB[Gi] = PB; PB = EA[Gi] * PB + EB[Gi]; PA = EA[Gi] * PA; }
    TA = PA; TB = PB;
#pragma unroll
    for (int g = 0; g < 4; ++g) { const float oA = hi ? preA[2 * g + 1] : preA[2 * g], oB = hi ? preB[2 * g + 1] : preB[2 * g];
#pragma unroll
        for (int i = 0; i < 4; ++i) { u[4 * g + i] = a[4 * g + i] * oB + u[4 * g + i]; a[4 * g + i] = a[4 * g + i] * oA; } }
}

__device__ __forceinline__ void rg_load_x(unsigned long long (&x)[19], const bf16* XB, int seq_row0, int t0, int T, int n, int tid) {
    const int cg = tid & 31, tg = tid >> 5, tb = t0 + 16 * tg - 1;
    const bf16* xp = XB + ((size_t)seq_row0 + tb) * 2048 + n * 128 + 4 * cg;
#pragma unroll
    for (int k = 0; k < 19; ++k) {
        if (k == 0 || k >= 17) { const int t = tb + k, tc = t < 0 ? 0 : (t >= T ? T - 1 : t); const unsigned long long v = *(const unsigned long long*)(xp + (ptrdiff_t)(tc - tb) * 2048); x[k] = (t >= 0 && t < T) ? v : 0ull; }
        else x[k] = *(const unsigned long long*)(xp + (size_t)k * 2048);
    }
}
__device__ __forceinline__ f32x4 bf4_to_f32(unsigned long long v) { const unsigned lo = (unsigned)v, hi = (unsigned)(v >> 32);
    f32x4 o; o.x = __builtin_bit_cast(float, lo << 16); o.y = __builtin_bit_cast(float, lo & 0xffff0000u); o.z = __builtin_bit_cast(float, hi << 16); o.w = __builtin_bit_cast(float, hi & 0xffff0000u); return o; }
template <bool DO_F, bool DO_B, bool LOAD_HF>
__device__ __forceinline__ void rg_step(LAS unsigned char* lds, const bf16* XB, float* HF, const bf16* GT, bf16* MIX, int seq_row0, int t0, int T, int n, int sub, int ch, int tid, int lane, int wave,
                                        f32x4 w0, f32x4 w1, f32x4 w2, f32x4 w3, f32x4 cb, float ba0, float bx0, float cf0, float ba1, float bx1, float cf1, float& Sf, float& Sb,
                                        unsigned long long (&xr)[19], int nrow0, int nt0, int nT, bool has_next, int par) {
    asm volatile("" : "+v"(tid), "+v"(lane));
    const int cg = tid & 31, tg = tid >> 5, c = lane & 31, hh = lane >> 5; const bool hi = lane >= 32;
    {
        f32x4 xa = bf4_to_f32(xr[0]), xb_ = bf4_to_f32(xr[1]), xc_ = bf4_to_f32(xr[2]);
#pragma unroll
        for (int i = 0; i < 16; ++i) {
            const f32x4 xd = bf4_to_f32(xr[i + 3]);
            const f32x4 v = cb + w0 * xa + w1 * xb_ + w2 * xc_ + w3 * xd;
            xa = xb_; xb_ = xc_; xc_ = xd;
            const int lr = 16 * tg + i;
            *(LAS unsigned long long*)(lds + RG_AIMG + swz16(lr, 8 * cg)) = pack4(v);
        }
    }
    if (has_next) rg_load_x(xr, XB, nrow0, nt0, nT, n, tid);
    const int ch0 = ch - c;
    const size_t trow0 = (size_t)seq_row0 + t0 + 32 * wave;
    LAS unsigned char* stg = lds + RG_STG + wave * 2048;
    v4u gte4[2]; float hfe[16];
    constexpr bool EARLY = DO_B && !DO_F;
    if (EARLY) {
#pragma unroll
        for (int i = 0; i < 2; ++i) gte4[i] = *(const v4u*)(GT + (trow0 + (lane >> 2) + 16 * i) * 2048 + ch0 + 8 * (lane & 3));
        if (LOAD_HF) {
#pragma unroll
            for (int q = 0; q < 16; ++q) hfe[q] = HF[(trow0 + crow16(q, hh) - MP) * 2048 + ch];
        }
    }
    f32x16 acc[4];
#pragma unroll
    for (int e = 0; e < 4; ++e)
#pragma unroll
        for (int q = 0; q < 16; ++q) acc[e][q] = 0.f;
    {
        bf16x8 A[8];
        const int row = 32 * wave + c;
#pragma unroll
        for (int s = 0; s < 8; ++s) A[s] = *(const LAS bf16x8*)(lds + RG_AIMG + swz16(row, (2 * s + hh) * 16));
#pragma unroll
        for (int e = 0; e < 4; ++e) {
            if ((e < 2 && !DO_F) || (e >= 2 && !DO_B)) continue;
            bf16x8 Bf[8];
#pragma unroll
            for (int s = 0; s < 8; ++s) Bf[s] = *(const LAS bf16x8*)(lds + RG_BIMG + e * 8192 + swz16(c, (2 * s + hh) * 16));
            asm volatile("" : "+v"(Bf[0]), "+v"(Bf[1]), "+v"(Bf[2]), "+v"(Bf[3]), "+v"(Bf[4]), "+v"(Bf[5]), "+v"(Bf[6]), "+v"(Bf[7]));
#pragma unroll
            for (int s = 0; s < 8; ++s) acc[e] = __builtin_amdgcn_mfma_f32_32x32x16_bf16(A[s], Bf[s], acc[e], 0, 0, 0);
        }
    }
    float af[16], uf[16], ab[16], ub[16];
#pragma unroll
    for (int q = 0; q < 16; ++q) {
        const float xc = bf2f(*(const LAS unsigned short*)(lds + RG_AIMG + swz16(32 * wave + crow16(q, hh), 64 * sub + 2 * c)));
        if (DO_F) rg_elem(acc[0][q] + ba0, acc[1][q] + bx0, cf0, xc, af[q], uf[q]);
        if (DO_B) rg_elem(acc[2][q] + ba1, acc[3][q] + bx1, cf1, xc, ab[q], ub[q]);
    }
    float TAf = 1.f, TBf = 0.f, TAb = 1.f, TBb = 0.f;
    if (DO_F) rg_scan_tile<false>(af, uf, hi, TAf, TBf);
    if (DO_B) rg_scan_tile<true>(ab, ub, hi, TAb, TBb);
    LAS f32x2v* SUM = (LAS f32x2v*)(lds + RG_SUM + par * 4096);
    if (hh == 0) { if (DO_F) SUM[(0 * 8 + wave) * 32 + c] = (f32x2v){TAf, TBf}; if (DO_B) SUM[(1 * 8 + wave) * 32 + c] = (f32x2v){TAb, TBb}; }
    __syncthreads();
    float Cf = 0.f, Cb = 0.f;
    if (DO_F) { float S = Sf;
#pragma unroll
        for (int w = 0; w < 8; ++w) { const f32x2v v = SUM[(0 * 8 + w) * 32 + c]; if (w == wave) Cf = S; S = v.x * S + v.y; }
        Sf = S; }
    if (DO_B) { float S = Sb;
#pragma unroll
        for (int w = 7; w >= 0; --w) { const f32x2v v = SUM[(1 * 8 + w) * 32 + c]; if (w == wave) Cb = S; S = v.x * S + v.y; }
        Sb = S; }
    if (DO_F && !DO_B) {
#pragma unroll
        for (int q = 0; q < 16; ++q) HF[(trow0 + crow16(q, hh) - MP) * 2048 + ch] = uf[q] + af[q] * Cf;
    } else {
        if (!EARLY) {
#pragma unroll
            for (int i = 0; i < 2; ++i) gte4[i] = *(const v4u*)(GT + (trow0 + (lane >> 2) + 16 * i) * 2048 + ch0 + 8 * (lane & 3));
        }
#pragma unroll
        for (int i = 0; i < 2; ++i) *(LAS v4u*)(stg + ((lane >> 2) + 16 * i) * 64 + 16 * (lane & 3)) = gte4[i];
        float yg[16];
#pragma unroll
        for (int q = 0; q < 16; ++q) {
            const float hfv = LOAD_HF ? hfe[q] : (uf[q] + af[q] * Cf);
            const float y = hfv + (ub[q] + ab[q] * Cb);
            yg[q] = y * bf2f(*(const LAS unsigned short*)(stg + crow16(q, hh) * 64 + 2 * c));
        }
#pragma unroll
        for (int q = 0; q < 16; ++q) *(LAS unsigned short*)(stg + crow16(q, hh) * 64 + 2 * c) = (unsigned short)(pg8::cvt_pk_bf16(yg[q], 0.f) & 0xffffu);
#pragma unroll
        for (int i = 0; i < 2; ++i) { const v4u v = *(const LAS v4u*)(stg + ((lane >> 2) + 16 * i) * 64 + 16 * (lane & 3));
            *(v4u*)(MIX + (trow0 + (lane >> 2) + 16 * i) * 2048 + ch0 + 8 * (lane & 3)) = v; }
    }
}

__device__ __forceinline__ void ph_rg_fused(const Args& a, int zz, int jl, LAS unsigned char* lds, int tid, int lane, int wave, int G) {
    PH_LOCALS;
    const bf16* XB = (const bf16*)(ws + WS_XB); float* HF = (float*)(ws + WS_HF);
    const bf16* GT = (const bf16*)(ws + WS_GATE); bf16* MIX = (bf16*)(ws + WS_MIX);
    const int bx = blockIdx.x, vcu = (G % 8 == 0) ? (bx % 8) * (G / 8) + bx / 8 : bx;
    const int c = lane & 31, hh = lane >> 5, cg = tid & 31;
#pragma unroll 1
    for (int u = vcu; u < 256; u += G) {
        int n, sub, b0; const bool samp = u < 128;
        if (samp) { b0 = u >> 6; n = (u & 63) >> 2; sub = u & 3; } else { const int pu = u - 128; n = pu >> 3; sub = (pu >> 1) & 3; b0 = (pu & 1) * 8; }
        const int ch = n * 128 + sub * 32 + c;
        const float ba0 = a.in[zz + I_BRGA][(jl * 2 + 0) * 2048 + ch], ba1 = a.in[zz + I_BRGA][(jl * 2 + 1) * 2048 + ch];
        const float bx0 = a.in[zz + I_BRGX][(jl * 2 + 0) * 2048 + ch], bx1 = a.in[zz + I_BRGX][(jl * 2 + 1) * 2048 + ch];
        const float cf0 = rg_coef(a.in[zz + I_LAM][(jl * 2 + 0) * 2048 + ch]), cf1 = rg_coef(a.in[zz + I_LAM][(jl * 2 + 1) * 2048 + ch]);
        const float* cwp = a.in[zz + I_CONVW] + (size_t)jl * 4 * 2048 + n * 128 + 4 * cg;
        const f32x4 w0 = *(const f32x4*)cwp, w1 = *(const f32x4*)(cwp + 2048), w2 = *(const f32x4*)(cwp + 4096), w3 = *(const f32x4*)(cwp + 6144);
        const f32x4 cb = *(const f32x4*)(a.in[zz + I_CONVB] + (size_t)jl * 2048 + n * 128 + 4 * cg);
        __syncthreads();
        {
            const int kl = tid & 31, jg = tid >> 5;
#pragma unroll
            for (int e = 0; e < 4; ++e) {
                const float* src = ((e & 1) ? a.in[zz + I_WRGX] : a.in[zz + I_WRGA]) + ((size_t)((jl * 2 + (e >> 1)) * 16 + n) * 128 + 8 * jg) * 128 + sub * 32 + kl;
                f32x4 f0, f1; f0.x = src[0]; f0.y = src[128]; f0.z = src[256]; f0.w = src[384]; f1.x = src[512]; f1.y = src[640]; f1.z = src[768]; f1.w = src[896];
                *(LAS v4u*)(lds + RG_BIMG + e * 8192 + swz16(kl, 16 * jg)) = pack8(f0, f1);
            }
        }
        __syncthreads();
        unsigned long long xr[19]; int stepc = 0;
        if (samp) {
            const int srow0 = MP + b0 * 2048;
            float Sf = a.in[zz + I_STATE][((size_t)(b0 * 2 + jl) * 2 + 0) * 2048 + ch], Sb = a.in[zz + I_STATE][((size_t)(b0 * 2 + jl) * 2 + 1) * 2048 + ch];
            rg_load_x(xr, XB, srow0, 0, 2048, n, tid);
#pragma unroll 1
            for (int ss = 0; ss < 8; ++ss) rg_step<true, false, false>(lds, XB, HF, GT, MIX, srow0, 256 * ss, 2048, n, sub, ch, tid, lane, wave, w0, w1, w2, w3, cb, ba0, bx0, cf0, ba1, bx1, cf1, Sf, Sb,
                                                                      xr, srow0, ss < 7 ? 256 * (ss + 1) : 256 * 7, 2048, true, (stepc++) & 1);
#pragma unroll 1
            for (int ss = 7; ss >= 0; --ss) rg_step<false, true, true>(lds, XB, HF, GT, MIX, srow0, 256 * ss, 2048, n, sub, ch, tid, lane, wave, w0, w1, w2, w3, cb, ba0, bx0, cf0, ba1, bx1, cf1, Sf, Sb,
                                                                       xr, srow0, ss > 0 ? 256 * (ss - 1) : 0, 2048, ss > 0, (stepc++) & 1);
        } else {
            rg_load_x(xr, XB, b0 * 256, 0, 256, n, tid);
#pragma unroll 1
            for (int bb = 0; bb < 8; ++bb) {
                const int b = b0 + bb; float Sf = 0.f, Sb = 0.f;
                rg_step<true, true, false>(lds, XB, HF, GT, MIX, b * 256, 0, 256, n, sub, ch, tid, lane, wave, w0, w1, w2, w3, cb, ba0, bx0, cf0, ba1, bx1, cf1, Sf, Sb, xr, (bb < 7 ? b + 1 : b) * 256, 0, 256, bb < 7, (stepc++) & 1);
                if (wave == 0 && hh == 0) { out[OUT_ST + ((size_t)(b * 2 + jl) * 2 + 0) * 2048 + ch] = Sf; out[OUT_ST + ((size_t)(b * 2 + jl) * 2 + 1) * 2048 + ch] = Sb; }
            }
        }
    }
}

#define RUN(p) (lo <= (p) && (p) < hi)
#define PH_BEGIN int zz = 0; asm volatile("" : "+s"(zz)); int lane_ = (int)__builtin_amdgcn_mbcnt_hi(~0u, __builtin_amdgcn_mbcnt_lo(~0u, 0u)); asm volatile("" : "+v"(lane_)); const int lane = lane_, wave = wave_k, tid = wave_k * 64 + lane_; \
    unsigned char* const ws = args.ws + zz; const int G = (int)gridDim.x + zz; (void)lane; (void)wave; (void)ws; (void)G
#define SEAM(p) do { if ((p) + 1 < hi) { XcdBarrier b2; b2.bar = (unsigned*)(args.ws + zz) + 4096; b2.x = xb_xcc_id(); b2.st = (volatile LAS unsigned*)(lds + LDSCTL_OFF); for (int repb_ = 0; repb_ < MK_REP_BAR; ++repb_) xcd_barrier(b2); } } while (0)
template <int l> __device__ __forceinline__ void run_layer(const Args& args, LAS unsigned char* lds, unsigned char* lds_raw, const int lo, const int hi, const int wave_k) {
    constexpr int pb = 3 + 10 * l, j = l >> 1;
        if constexpr ((l & 1) == 0) {
            if (RUN(pb + 0)) { PH_BEGIN;
                pg8::Gemm g{(const pg8::bf16_t*)(ws + WS_XN), (const pg8::bf16_t*)(ws + WS_WRGINT) + (size_t)j * RGW * D, M, RGW, D}; pg8::StaticOrder S; S.init(M, RGW, G, (int)blockIdx.x);
                pg8::EpiRgIn E{(pg8::bf16_t*)(ws + WS_GATE), (pg8::bf16_t*)(ws + WS_XB)};
                for (int rep_ = 0; rep_ < MK_REP_GEMM; ++rep_) pg8::gemm_phase<pg8::EpiRgIn, pg8::StaticOrder, MK_ALIGN, MK_SP2>(lds, g, S, E, wave);
                SEAM(pb + 0);
            }
#if MK_NAIVE_RG
            if (RUN(pb + 1)) { PH_BEGIN; ph_rg_conv_naive(args, zz, j, tid, G); SEAM(pb + 1); }
            if (RUN(pb + 2)) { PH_BEGIN; ph_rg_gates_naive(args, zz, j, tid, G); SEAM(pb + 2); }
            if (RUN(pb + 3)) { PH_BEGIN; ph_rg_scan_naive(args, zz, j, tid, G); SEAM(pb + 3); }
            if (RUN(pb + 4)) { PH_BEGIN; ph_rg_y_naive(args, zz, tid, G); SEAM(pb + 4); }
#else
            if (RUN(pb + 2)) { PH_BEGIN; for (int rep_ = 0; rep_ < MK_REP_RG; ++rep_) ph_rg_fused(args, zz, j, lds, tid, lane, wave, G); SEAM(pb + 2); }
#endif
        } else {
            if (RUN(pb + 0)) { PH_BEGIN;
                pg8::Gemm g{(const pg8::bf16_t*)(ws + WS_XN), (const pg8::bf16_t*)(ws + WS_WQKVT) + (size_t)j * NQKV * D, M, NQKV, D}; pg8::StaticOrder S; S.init(M, NQKV, G, (int)blockIdx.x);
                pg8::EpiBf16T<false> E{(pg8::bf16_t*)(ws + WS_QKV), NQKV};
                for (int rep_ = 0; rep_ < MK_REP_GEMM; ++rep_) pg8::gemm_phase<pg8::EpiBf16T<false>, pg8::StaticOrder, MK_ALIGN, MK_SP2>(lds, g, S, E, wave);
                SEAM(pb + 0);
            }
            if (RUN(pb + 1)) { PH_BEGIN; for (int rep_ = 0; rep_ < MK_REP_QK; ++rep_) ph_qknorm(args, zz, j, lane, wave, G); SEAM(pb + 1); }
            if (RUN(pb + 2)) { PH_BEGIN;
#if MK_NAIVE_ATTN
                ph_attn_naive(args, zz, j, tid, G);
#else
                for (int rep_ = 0; rep_ < MK_REP_ATT; ++rep_) ph_attn(args, zz, j, lds_raw, tid, G);
#endif
                SEAM(pb + 2);
            }
        }
        if (RUN(pb + 5)) { PH_BEGIN;
            const pg8::bf16_t* Wt = (l & 1) ? (const pg8::bf16_t*)(ws + WS_WOT) + (size_t)j * D * D : (const pg8::bf16_t*)(ws + WS_WRGOUTT) + (size_t)j * D * D;
            pg8::Gemm g{(const pg8::bf16_t*)(ws + WS_MIX), Wt, M, D, D}; pg8::StaticOrder S; S.init(M, D, G, (int)blockIdx.x);
            pg8::EpiBf16T<false> E{(pg8::bf16_t*)(ws + WS_BR), D};
            for (int rep_ = 0; rep_ < MK_REP_GEMM; ++rep_) pg8::gemm_phase<pg8::EpiBf16T<false>, pg8::StaticOrder, MK_ALIGN, MK_SP2>(lds, g, S, E, wave);
            SEAM(pb + 5);
        }
        if (RUN(pb + 6)) { PH_BEGIN; for (int rep_ = 1; rep_ < MK_REP_POST; ++rep_) ph_post(args, zz, l, 0, lane, wave, G, true); ph_post(args, zz, l, 0, lane, wave, G); SEAM(pb + 6); }
        if (RUN(pb + 7)) { PH_BEGIN;
            pg8::Gemm g{(const pg8::bf16_t*)(ws + WS_XN), (const pg8::bf16_t*)(ws + WS_W1T) + (size_t)l * FF * D, M, FF, D}; pg8::StaticOrder S; S.init(M, FF, G, (int)blockIdx.x);
            pg8::EpiBf16T<true> E{(pg8::bf16_t*)(ws + WS_H), FF};
            for (int rep_ = 0; rep_ < MK_REP_FF1; ++rep_) pg8::gemm_phase<pg8::EpiBf16T<true>, pg8::StaticOrder, MK_ALIGN, MK_SP2>(lds, g, S, E, wave);
            SEAM(pb + 7);
        }
        if (RUN(pb + 8)) { PH_BEGIN;
            pg8::Gemm g{(const pg8::bf16_t*)(ws + WS_H), (const pg8::bf16_t*)(ws + WS_W2T) + (size_t)l * D * FF, M, D, FF}; pg8::StaticOrder S; S.init(M, D, G, (int)blockIdx.x);
            pg8::EpiBf16T<false> E{(pg8::bf16_t*)(ws + WS_BR), D};
            for (int rep_ = 0; rep_ < MK_REP_FF2; ++rep_) pg8::gemm_phase<pg8::EpiBf16T<false>, pg8::StaticOrder, MK_ALIGN, MK_SP2>(lds, g, S, E, wave);
            SEAM(pb + 8);
        }
        if (RUN(pb + 9)) { PH_BEGIN; for (int rep_ = 1; rep_ < MK_REP_POST; ++rep_) ph_post(args, zz, l, 1, lane, wave, G, true); ph_post(args, zz, l, 1, lane, wave, G); SEAM(pb + 9); }
}

__global__ void __launch_bounds__(NTHR, 2) mk_fwd(Args args) {
    extern __shared__ __attribute__((aligned(16))) unsigned char lds_raw[];
    LAS unsigned char* lds = (LAS unsigned char*)lds_raw;
    if (threadIdx.x < 128) ((LAS unsigned*)(lds + LDSCTL_OFF))[threadIdx.x] = 0u;
    __syncthreads();
    (void)xcd_barrier_post((unsigned*)(args.ws + WS_CTL) + 4096, (volatile LAS unsigned*)(lds + LDSCTL_OFF));
    const int lo = args.ph_lo, hi = args.ph_hi;
    const int wave_k = __builtin_amdgcn_readfirstlane(threadIdx.x >> 6);
    if (RUN(0)) { PH_BEGIN; for (int rep_ = 0; rep_ < MK_REP_PRO; ++rep_) ph_prologue(args, zz, lds, tid, lane, wave, G); SEAM(0); }
    if (RUN(1)) { PH_BEGIN; ph_modreduce(args, zz, tid, G); SEAM(1); }
    if (RUN(2)) { PH_BEGIN; ph_pre0(args, zz, lane, wave, G); SEAM(2); }

    run_layer<0>(args, lds, lds_raw, lo, hi, wave_k); run_layer<1>(args, lds, lds_raw, lo, hi, wave_k); run_layer<2>(args, lds, lds_raw, lo, hi, wave_k); run_layer<3>(args, lds, lds_raw, lo, hi, wave_k);
#undef RUN
#undef SEAM
#undef PH_BEGIN
}

extern "C" void kernel_launch(void* const* d_in, const int* in_sizes, int n_in, void* d_out, int out_size, void* d_ws, size_t ws_size, hipStream_t stream) {
    static int grid = 0;
    if (grid == 0) {
        if (n_in != N_IN || out_size != OUT_TOTAL || ws_size < WS_END) { fprintf(stderr, "kernel_launch: built for %d inputs, %d outputs, >= %zu bytes of workspace; got %d, %d, %zu; nothing launched\n", (int)N_IN, OUT_TOTAL, (size_t)WS_END, n_in, out_size, ws_size); grid = -1; return; }
        int dev = 0, cus = 0, per_cu = 0;
        if (hipGetDevice(&dev) != hipSuccess || hipDeviceGetAttribute(&cus, hipDeviceAttributeMultiprocessorCount, dev) != hipSuccess) { fprintf(stderr, "kernel_launch: device query failed\n"); grid = -1; return; }
        if (hipFuncSetAttribute((const void*)mk_fwd, hipFuncAttributeMaxDynamicSharedMemorySize, LDS_BYTES) != hipSuccess) { fprintf(stderr, "kernel_launch: hipFuncSetAttribute failed\n"); grid = -1; return; }
        if (hipOccupancyMaxActiveBlocksPerMultiprocessor(&per_cu, (const void*)mk_fwd, NTHR, LDS_BYTES) != hipSuccess || per_cu < 1) fprintf(stderr, "kernel_launch: note: occupancy query reports %d workgroups per CU\n", per_cu);
        (void)hipGetLastError();
        grid = cus;
    }
    if (grid < 0) return;
    if (hipMemsetAsync((char*)d_ws + WS_CTL, 0, CTL_ZERO_BYTES, stream) != hipSuccess) { fprintf(stderr, "kernel_launch: memset failed\n"); return; }
    Args a{};
    for (int i = 0; i < N_IN; ++i) a.in[i] = (const float*)d_in[i];
    a.out = (float*)d_out; a.ws = (unsigned char*)d_ws;
#if MK_ONE_LAUNCH
    a.ph_lo = 0; a.ph_hi = NPH;
    hipLaunchKernelGGL(mk_fwd, dim3(grid), dim3(NTHR), LDS_BYTES, stream, a);
#else
    for (int p = 0; p < NPH; ++p) {
        if (!phase_active(p)) continue;
        a.ph_lo = p; a.ph_hi = p + 1;
        hipLaunchKernelGGL(mk_fwd, dim3(grid), dim3(NTHR), LDS_BYTES, stream, a);
    }
#endif
    const hipError_t le = hipPeekAtLastError();
    if (le != hipSuccess) fprintf(stderr, "kernel_launch: launch failed: %s\n", hipGetErrorName(le));
}
```

```cpp
#include <hip/hip_runtime.h>
#include <hip/hip_bf16.h>
#include <cstdio>
#include <cstdint>

#ifndef MK_ONE_LAUNCH
#define MK_ONE_LAUNCH 1
#endif
#ifndef MK_NAIVE_RG
#define MK_NAIVE_RG 0
#endif
#ifndef MK_NAIVE_ATTN
#define MK_NAIVE_ATTN 0
#endif
#ifndef MK_REP_GEMM
#define MK_REP_GEMM 1
#endif
#define MK_REP_PRO 1
#define MK_REP_PRO_T 1
#define MK_REP_PRO_G 1
#define MK_REP_RG 1
#define MK_REP_QK 1
#define MK_REP_ATT 1
#define MK_REP_POST 1
#define MK_REP_BAR 1
#ifndef MK_ST_SC1
#define MK_ST_SC1 0
#endif
#ifndef MK_SP2
#define MK_SP2 true
#endif
#ifndef MK_ALIGN
#define MK_ALIGN true
#endif
#ifndef MK_ST_NT
#define MK_ST_NT 0
#endif
#define MK_REP_FF1 1
#define MK_REP_FF2 1
#ifndef MK_H_SC1
#define MK_H_SC1 0
#endif
namespace pg8 {
#define PG8_LAS __attribute__((address_space(3)))
typedef unsigned short bf16_t;
typedef short bf16x8 __attribute__((ext_vector_type(8)));
typedef float f32x4 __attribute__((ext_vector_type(4)));
typedef unsigned u32x4 __attribute__((ext_vector_type(4)));
constexpr int BM = 256, BK = 64, HALF = 128, HTB = HALF * BK * 2  , STAGE_BYTES = 8 * HTB, NXCD = 8, WGM = 8;

__host__ __device__ __forceinline__ int lds_byte(int r, int c) { const int st = (r >> 4) * 2 + (c >> 5), rr = r & 15, cc = c & 31, ob = rr * 64 + cc * 2; return st * 1024 + (ob ^ (((ob >> 9) & 1) << 5)); }
__host__ __device__ __forceinline__ void stage_rc(int b, int& R, int& C) { const int st = b / 1024, sb = b % 1024, swz = sb ^ (((sb >> 9) & 1) << 5); R = (st >> 1) * 16 + swz / 64; C = (st & 1) * 32 + (swz % 64) / 2; }
__host__ __device__ __forceinline__ int perm32(int rho) { const int n = rho >> 4, i = rho & 15; return 8 * (i >> 2) + 4 * n + (i & 3); }

struct Unit { int pm, pn; };
struct Gemm { const bf16_t* A; const bf16_t* Bt; int M, N, K; };

struct StaticOrder {
    int nM, nN, nwg, G, c;
    __host__ __device__ void init(int M, int N, int G_, int c_) { nM = M / BM; nN = N / BM; nwg = nM * nN; G = G_; c = c_; }
    __host__ __device__ bool next(int i, Unit& u) const {
        const long L = (long)i * G + c; if (L >= nwg) return false;
        int wgid = (int)L; { const int q = nwg / NXCD, r = nwg % NXCD, xcd = wgid % NXCD, off = wgid / NXCD; wgid = (xcd < r ? xcd * (q + 1) : r * (q + 1) + (xcd - r) * q) + off; }
        const int nig = WGM * nN, gid = wgid / nig, fm = gid * WGM, gsz = (nM - fm) < WGM ? (nM - fm) : WGM;
        u.pm = fm + ((wgid % nig) % gsz); u.pn = (wgid % nig) / gsz; return true;
    }
    __device__ __forceinline__ void a_ready(const Unit&) const {}
    __device__ __forceinline__ void done(const Unit&) const {}
};

__device__ __forceinline__ unsigned cvt_pk_bf16(float lo, float hi) { unsigned r; asm volatile("v_cvt_pk_bf16_f32 %0, %1, %2" : "=v"(r) : "v"(lo), "v"(hi)); return r; }
typedef float f32x2 __attribute__((ext_vector_type(2)));
#if MK_ST_SC1
__device__ __forceinline__ void st16(void* p, u32x4 v) { asm volatile("global_store_dwordx4 %0, %1, off sc1\n\ts_nop 1" :: "v"(p), "v"(v) : "memory"); }
#elif MK_ST_NT
__device__ __forceinline__ void st16(void* p, u32x4 v) { __builtin_nontemporal_store(v, (u32x4*)p); }
#else
__device__ __forceinline__ void st16(void* p, u32x4 v) { *(u32x4*)p = v; }
#endif
__device__ __forceinline__ void st16_sc1(void* p, u32x4 v) { asm volatile("global_store_dwordx4 %0, %1, off sc1\n\ts_nop 1" :: "v"(p), "v"(v) : "memory"); }
__device__ __forceinline__ void st16f(void* p, f32x4 v) { st16(p, __builtin_bit_cast(u32x4, v)); }
struct EpiF32 {
    static constexpr bool PERM = false, AFTER_DRAIN = false;
    float* C; int ldc;
    __device__ __forceinline__ void operator()(const f32x4 (&acc)[2][2][4][2], const Unit& u, int wr, int wc, int fr, int fq) const {
        const int row0 = u.pm * BM + wr * 64 + fr, col0 = u.pn * BM + wc * 32 + 4 * fq;
#pragma unroll
        for (int ai = 0; ai < 2; ++ai)
#pragma unroll
            for (int m = 0; m < 4; ++m) { float* rowp = C + (size_t)(row0 + ai * HALF + m * 16) * ldc + col0;
#pragma unroll
                for (int bj = 0; bj < 2; ++bj)
#pragma unroll
                    for (int n = 0; n < 2; ++n) st16f(rowp + bj * HALF + n * 16, acc[ai][bj][m][n]); }
    }
};
template <bool RELU2> struct EpiBf16T {
    static constexpr bool PERM = true, AFTER_DRAIN = false;
    bf16_t* O; int ldc;
    __device__ __forceinline__ void operator()(const f32x4 (&acc)[2][2][4][2], const Unit& u, int wr, int wc, int fr, int fq) const {
        const int row0 = u.pm * BM + wr * 64 + fr, col0 = u.pn * BM + wc * 32 + 8 * fq;
#pragma unroll
        for (int ai = 0; ai < 2; ++ai)
#pragma unroll
            for (int m = 0; m < 4; ++m) { bf16_t* rowp = O + (size_t)(row0 + ai * HALF + m * 16) * ldc + col0;
#pragma unroll
                for (int bj = 0; bj < 2; ++bj) { f32x4 v0 = acc[ai][bj][m][0], v1 = acc[ai][bj][m][1];
                    if (RELU2) { v0 = __builtin_elementwise_max(v0, (f32x4){0.f, 0.f, 0.f, 0.f}); v1 = __builtin_elementwise_max(v1, (f32x4){0.f, 0.f, 0.f, 0.f}); v0 = v0 * v0; v1 = v1 * v1; }
                    u32x4 w; w.x = cvt_pk_bf16(v0[0], v0[1]); w.y = cvt_pk_bf16(v0[2], v0[3]); w.z = cvt_pk_bf16(v1[0], v1[1]); w.w = cvt_pk_bf16(v1[2], v1[3]);
                    if (RELU2 && MK_H_SC1) st16_sc1(rowp + bj * HALF, w); else st16(rowp + bj * HALF, w); } }
    }
};
__device__ __forceinline__ float gelu_tanh_f(float v) {
    const float u = v * (0.7978845608028654f + 0.035677408136300125f * v * v);
    const float t = __builtin_amdgcn_exp2f(-2.885390081777927f * u);
    return v * __builtin_amdgcn_rcpf(1.0f + t);
}
struct EpiRgIn {
    static constexpr bool PERM = true, AFTER_DRAIN = false;
    bf16_t* G; bf16_t* XB;
    __device__ __forceinline__ void operator()(const f32x4 (&acc)[2][2][4][2], const Unit& u, int wr, int wc, int fr, int fq) const {
        const int row0 = u.pm * BM + wr * 64 + fr;
        if (u.pn < 8) {
            const int col0 = u.pn * BM + wc * 32 + 8 * fq;
#pragma unroll
            for (int ai = 0; ai < 2; ++ai)
#pragma unroll
                for (int m = 0; m < 4; ++m) { bf16_t* rowp = G + (size_t)(row0 + ai * HALF + m * 16) * 2048 + col0;
#pragma unroll
                    for (int bj = 0; bj < 2; ++bj) { const f32x4 v0 = acc[ai][bj][m][0], v1 = acc[ai][bj][m][1];
                        u32x4 w; w.x = cvt_pk_bf16(gelu_tanh_f(v0[0]), gelu_tanh_f(v0[1])); w.y = cvt_pk_bf16(gelu_tanh_f(v0[2]), gelu_tanh_f(v0[3]));
                        w.z = cvt_pk_bf16(gelu_tanh_f(v1[0]), gelu_tanh_f(v1[1])); w.w = cvt_pk_bf16(gelu_tanh_f(v1[2]), gelu_tanh_f(v1[3]));
                        st16(rowp + bj * HALF, w); } }
        } else {
            const int col0 = (u.pn - 8) * BM + wc * 32 + 8 * fq;
#pragma unroll
            for (int ai = 0; ai < 2; ++ai)
#pragma unroll
                for (int m = 0; m < 4; ++m) { bf16_t* rowp = XB + (size_t)(row0 + ai * HALF + m * 16) * 2048 + col0;
#pragma unroll
                    for (int bj = 0; bj < 2; ++bj) { const f32x4 v0 = acc[ai][bj][m][0], v1 = acc[ai][bj][m][1];
                        u32x4 w; w.x = cvt_pk_bf16(v0[0], v0[1]); w.y = cvt_pk_bf16(v0[2], v0[3]); w.z = cvt_pk_bf16(v1[0], v1[1]); w.w = cvt_pk_bf16(v1[2], v1[3]);
                        st16(rowp + bj * HALF, w); } }
        }
    }
};
template <class Epi, class Sched, bool ALIGN_EPI = false, bool SP2 = false>
__device__ __forceinline__ void gemm_phase(PG8_LAS unsigned char* lds, const Gemm g, const Sched& S, const Epi& E, const int wave_id) {
    const int wid = __builtin_amdgcn_readfirstlane(wave_id); int lane_l = (int)__builtin_amdgcn_mbcnt_hi(~0u, __builtin_amdgcn_mbcnt_lo(~0u, 0u)); asm volatile("" : "+v"(lane_l)); const int tid = wid * 64 + lane_l, lane = tid & 63, wr = wid >> 2, wc = wid & 3, fr = lane & 15, fq = lane >> 4;
    const int K = g.K, nt = K / BK;
    unsigned voffA[2], voffB[2];
#pragma unroll
    for (int i = 0; i < 2; ++i) { int R, C; stage_rc(tid * 16 + i * 8192, R, C); const int Rb = Epi::PERM ? ((R & ~31) + perm32(R & 31)) : R;
        voffA[i] = (unsigned)(R * K + C) * 2u; voffB[i] = (unsigned)(Rb * K + C) * 2u; }
    const size_t kstep = (size_t)(BK * 2);
    const size_t hstep = (size_t)HALF * K * 2;
    const size_t tstep = 2 * hstep;
    const unsigned ldsw = (unsigned)wid * 1024u;
    const int aoff = lds_byte(wr * 64 + fr, fq * 8), boff = lds_byte(wc * 32 + fr, fq * 8);
#define PG8_SA(b, h) (((b) * 2 + (h)) * HTB)
#define PG8_SB(b, h) ((4 + (b) * 2 + (h)) * HTB)
#define PG8_STAGE(bufoff, gbase, voff) do { _Pragma("unroll") for (int _i = 0; _i < 2; ++_i) \
        __builtin_amdgcn_global_load_lds((const unsigned*)((const char*)(gbase) + (voff)[_i]), (PG8_LAS unsigned*)(lds + (bufoff) + ldsw + _i * 8192), 16, 0, 0); } while (0)
#define PG8_LDA(dst, b, h) do { _Pragma("unroll") for (int m = 0; m < 4; ++m) _Pragma("unroll") for (int k = 0; k < 2; ++k) dst[m][k] = *(const PG8_LAS bf16x8*)(lds + PG8_SA(b, h) + aoff + m * 2048 + k * 1024); } while (0)
#define PG8_LDB(dst, b, h) do { _Pragma("unroll") for (int n = 0; n < 2; ++n) _Pragma("unroll") for (int k = 0; k < 2; ++k) dst[n][k] = *(const PG8_LAS bf16x8*)(lds + PG8_SB(b, h) + boff + n * 2048 + k * 1024); } while (0)
#define PG8_MMA(ai, bj, At, Bt) do { __builtin_amdgcn_s_setprio(1); _Pragma("unroll") for (int m = 0; m < 4; ++m) _Pragma("unroll") for (int n = 0; n < 2; ++n) _Pragma("unroll") for (int k = 0; k < 2; ++k) \
        acc[ai][bj][m][n] = __builtin_amdgcn_mfma_f32_16x16x32_bf16(Bt[n][k], At[m][k], acc[ai][bj][m][n], 0, 0, 0); __builtin_amdgcn_s_setprio(0); } while (0)
#define PG8_WAIT_V(n) asm volatile("s_waitcnt vmcnt(" #n ")" ::: "memory")
#define PG8_WAIT_L(n) asm volatile("s_waitcnt lgkmcnt(" #n ")" ::: "memory")
#define PG8_BAR __builtin_amdgcn_s_barrier()
#define PG8_SCHED __builtin_amdgcn_sched_barrier(0)
    Unit cur, nxt; int ui = 0;
    if (!S.next(0, cur)) return;
    f32x4 acc[2][2][4][2];
#pragma unroll
    for (int a = 0; a < 2; ++a)
#pragma unroll
        for (int b = 0; b < 2; ++b)
#pragma unroll
            for (int m = 0; m < 4; ++m)
#pragma unroll
                for (int n = 0; n < 2; ++n) acc[a][b][m][n] = (f32x4){0.f, 0.f, 0.f, 0.f};
    bf16x8 At[4][2], B0[2][2], B1[2][2];
    const char* cA = (const char*)g.A + (size_t)cur.pm * tstep; const char* cB = (const char*)g.Bt + (size_t)cur.pn * tstep;
    S.a_ready(cur);
    if constexpr (SP2) {
        PG8_STAGE(PG8_SB(0, 0), cB, voffB); PG8_STAGE(PG8_SB(0, 1), cB + hstep, voffB); PG8_STAGE(PG8_SA(0, 0), cA, voffA); PG8_STAGE(PG8_SA(0, 1), cA + hstep, voffA);
        if (wr == 1) PG8_BAR;
        PG8_WAIT_V(2); PG8_BAR;
        PG8_STAGE(PG8_SB(1, 0), cB + kstep, voffB); PG8_STAGE(PG8_SA(1, 0), cA + kstep, voffA); PG8_STAGE(PG8_SB(1, 1), cB + hstep + kstep, voffB);
        PG8_WAIT_V(6); PG8_BAR;
    } else {
        PG8_STAGE(PG8_SB(0, 0), cB, voffB); PG8_STAGE(PG8_SA(0, 0), cA, voffA); PG8_STAGE(PG8_SB(0, 1), cB + hstep, voffB); PG8_STAGE(PG8_SA(0, 1), cA + hstep, voffA);
        if (wr == 1) PG8_BAR;
        PG8_WAIT_V(4); PG8_BAR;
        PG8_STAGE(PG8_SB(1, 0), cB + kstep, voffB); PG8_STAGE(PG8_SA(1, 0), cA + kstep, voffA); PG8_STAGE(PG8_SB(1, 1), cB + hstep + kstep, voffB);
        PG8_WAIT_V(6); PG8_BAR;
    }
    for (;;) {
        const bool has_next = S.next(ui + 1, nxt);
        const char* nA = has_next ? (const char*)g.A + (size_t)nxt.pm * tstep : cA; const char* nB = has_next ? (const char*)g.Bt + (size_t)nxt.pn * tstep : cB;
        for (int t = 0; t < nt; t += 2) {
            const bool last = (t == nt - 2);
            const char* a1 = cA + (size_t)(t + 1) * kstep;
            const char* a2 = last ? nA : cA + (size_t)(t + 2) * kstep; const char* b2 = last ? nB : cB + (size_t)(t + 2) * kstep;
            const char* a3 = a2 + kstep; const char* b3 = b2 + kstep;
            if (last && has_next) S.a_ready(nxt);
            if constexpr (SP2) {
            PG8_LDB(B0, 0, 0); PG8_LDB(B1, 0, 1); PG8_SCHED; PG8_LDA(At, 0, 0); PG8_STAGE(PG8_SA(1, 1), a1 + hstep, voffA);
            PG8_WAIT_V(8); PG8_WAIT_L(0); PG8_BAR; PG8_MMA(0, 0, At, B0); PG8_MMA(0, 1, At, B1); PG8_BAR; PG8_SCHED;
            PG8_LDA(At, 0, 1); PG8_STAGE(PG8_SB(0, 0), b2, voffB); PG8_STAGE(PG8_SB(0, 1), b2 + hstep, voffB); PG8_STAGE(PG8_SA(0, 0), a2, voffA);
            PG8_WAIT_V(8); PG8_WAIT_L(0); PG8_BAR; PG8_MMA(1, 0, At, B0); PG8_MMA(1, 1, At, B1); PG8_BAR; PG8_SCHED;
            PG8_LDB(B0, 1, 0); PG8_LDB(B1, 1, 1); PG8_SCHED; PG8_LDA(At, 1, 0); PG8_STAGE(PG8_SA(0, 1), a2 + hstep, voffA);
            PG8_WAIT_V(8); PG8_WAIT_L(0); PG8_BAR; PG8_MMA(0, 0, At, B0); PG8_MMA(0, 1, At, B1); PG8_BAR; PG8_SCHED;
            PG8_LDA(At, 1, 1); PG8_STAGE(PG8_SB(1, 0), b3, voffB); PG8_STAGE(PG8_SB(1, 1), b3 + hstep, voffB); PG8_STAGE(PG8_SA(1, 0), a3, voffA);
            PG8_WAIT_V(8); PG8_WAIT_L(0); PG8_BAR; PG8_MMA(1, 0, At, B0); PG8_MMA(1, 1, At, B1); PG8_BAR; PG8_SCHED;
            } else {
            PG8_LDB(B0, 0, 0); PG8_SCHED; PG8_LDA(At, 0, 0); PG8_STAGE(PG8_SA(1, 1), a1 + hstep, voffA);
            PG8_WAIT_L(8); PG8_BAR; PG8_WAIT_L(0); PG8_MMA(0, 0, At, B0); PG8_BAR; PG8_SCHED;
            PG8_LDB(B1, 0, 1); PG8_STAGE(PG8_SB(0, 0), b2, voffB);
            PG8_BAR; PG8_WAIT_L(0); PG8_MMA(0, 1, At, B1); PG8_BAR;
            PG8_LDA(At, 0, 1); PG8_STAGE(PG8_SA(0, 0), a2, voffA);
            PG8_BAR; PG8_WAIT_L(0); PG8_MMA(1, 0, At, B0); PG8_BAR; PG8_SCHED;
            PG8_STAGE(PG8_SB(0, 1), b2 + hstep, voffB);
            PG8_WAIT_V(6); PG8_BAR; PG8_MMA(1, 1, At, B1); PG8_BAR;
            PG8_LDB(B0, 1, 0); PG8_SCHED; PG8_LDA(At, 1, 0); PG8_STAGE(PG8_SA(0, 1), a2 + hstep, voffA);
            PG8_WAIT_L(8); PG8_BAR; PG8_WAIT_L(0); PG8_MMA(0, 0, At, B0); PG8_BAR; PG8_SCHED;
            PG8_LDB(B1, 1, 1); PG8_STAGE(PG8_SB(1, 0), b3, voffB);
            PG8_BAR; PG8_WAIT_L(0); PG8_MMA(0, 1, At, B1); PG8_BAR;
            PG8_LDA(At, 1, 1); PG8_STAGE(PG8_SA(1, 0), a3, voffA);
            PG8_BAR; PG8_WAIT_L(0); PG8_MMA(1, 0, At, B0); PG8_BAR; PG8_SCHED;
            PG8_STAGE(PG8_SB(1, 1), b3 + hstep, voffB);
            PG8_WAIT_V(6); PG8_BAR; PG8_MMA(1, 1, At, B1); PG8_BAR;
            }
        }
        if constexpr (ALIGN_EPI) { if (wr == 0) PG8_BAR; }
        if constexpr (!Epi::AFTER_DRAIN) { E(acc, cur, wr, wc, fr, fq); S.done(cur); }
        if (!has_next) break;
#pragma unroll
        for (int a = 0; a < 2; ++a)
#pragma unroll
            for (int b = 0; b < 2; ++b)
#pragma unroll
                for (int m = 0; m < 4; ++m)
#pragma unroll
                    for (int n = 0; n < 2; ++n) acc[a][b][m][n] = (f32x4){0.f, 0.f, 0.f, 0.f};
        cur = nxt; cA = nA; cB = nB; ++ui;
        if constexpr (ALIGN_EPI) { if (wr == 1) PG8_BAR; }
    }
    PG8_WAIT_V(0);
    if constexpr (!ALIGN_EPI) { if (wr == 0) PG8_BAR; }
    PG8_BAR;
    if constexpr (Epi::AFTER_DRAIN) { E.fused(acc, cur, wr, wc, fr, fq, lds, wid, lane); S.done(cur); }
#undef PG8_SA
#undef PG8_SB
#undef PG8_STAGE
#undef PG8_LDA
#undef PG8_LDB
#undef PG8_MMA
#undef PG8_WAIT_V
#undef PG8_WAIT_L
#undef PG8_BAR
#undef PG8_SCHED
}
}
#define GAS __attribute__((address_space(1)))
#define LAS __attribute__((address_space(3)))
typedef unsigned short bf16;
typedef unsigned v4u __attribute__((ext_vector_type(4)));
typedef float f32x4 __attribute__((ext_vector_type(4)));
typedef short bf16x8 __attribute__((ext_vector_type(8)));
typedef GAS unsigned gu32;
typedef GAS unsigned long long gu64;
#define RLX_AGENT __ATOMIC_RELAXED, __HIP_MEMORY_SCOPE_AGENT
#define LDS_WAIT() asm volatile("s_waitcnt lgkmcnt(0)" ::: "memory")
#define VM_WAIT() asm volatile("s_waitcnt vmcnt(0)" ::: "memory")
__device__ __forceinline__ unsigned long long rt() { return __builtin_amdgcn_s_memrealtime(); }
__device__ __forceinline__ unsigned f2bf(float f) { unsigned u = __builtin_bit_cast(unsigned, f); return (u + 0x7fffu + ((u >> 16) & 1u)) >> 16; }
__device__ __forceinline__ unsigned pk2(float lo, float hi) { return f2bf(lo) | (f2bf(hi) << 16); }
#define XB_TMO      128
#define XB_XCNT(j)  (256  + 64 * (j))
#define XB_XSUB(j)  (1280 + 64 * (j))
#define XB_XGEN(j)  (2304 + 64 * (j))
#define XB_TOP      3328
#define XB_TOPGEN   3392
#define XCD_BAR_WORDS 3456
#define XB_SPIN_CAP (1u << 18)

__device__ __forceinline__ unsigned xb_ld(unsigned* p)              { return __hip_atomic_load(p, __ATOMIC_RELAXED, __HIP_MEMORY_SCOPE_AGENT); }
__device__ __forceinline__ unsigned xb_add(unsigned* p, unsigned v) { return __hip_atomic_fetch_add(p, v, __ATOMIC_RELAXED, __HIP_MEMORY_SCOPE_AGENT); }
__device__ __forceinline__ unsigned xb_xcc_id() { return (unsigned)__builtin_amdgcn_s_getreg((3 << 11) | 20) & 0xFu; }
#define XB_SPIN(cond, bar) do { unsigned _sp = 0; while (cond) { __builtin_amdgcn_s_sleep(1); \
    if ((++_sp & 255u) == 0u) { if (xb_ld(&(bar)[XB_TMO])) break; if (_sp > XB_SPIN_CAP) { atomicAdd(&(bar)[XB_TMO], 1u); break; } } } } while (0)

struct XcdBarrier {
    unsigned* bar; unsigned x;
    volatile LAS unsigned* st;
};

__device__ __forceinline__ XcdBarrier xcd_barrier_post(unsigned* bar, volatile LAS unsigned* st) {
    XcdBarrier b; b.bar = bar; b.x = xb_xcc_id(); b.st = st;
    if (threadIdx.x == 0) (void)xb_add(&bar[XB_XCNT(b.x)], 1u);
    return b;
}
__device__ __forceinline__ void xcd_barrier_complete(unsigned* bar, unsigned x, unsigned& nloc, unsigned& nx) {
    const unsigned G = gridDim.x * gridDim.y * gridDim.z;
    unsigned sum, cnt, mine, sp = 0u;
    for (;;) {
        sum = 0u; cnt = 0u; mine = 0u;
#pragma unroll
        for (unsigned j = 0; j < 16; ++j) { const unsigned c = xb_ld(&bar[XB_XCNT(j)]); sum += c; cnt += (c > 0u) ? 1u : 0u; mine = (j == x) ? c : mine; }
        if (sum == G) break;
        __builtin_amdgcn_s_sleep(1);
        if ((++sp & 255u) == 0u) { if (xb_ld(&bar[XB_TMO])) break; if (sp > XB_SPIN_CAP) { atomicAdd(&bar[XB_TMO], 1u); break; } }
    }
    nloc = mine > 0u ? mine : 1u; nx = cnt > 0u ? cnt : 1u;
}

__device__ __forceinline__ void xcd_barrier(const XcdBarrier& b) {
    asm volatile("s_waitcnt vmcnt(0)" ::: "memory");
    __syncthreads();
    if (threadIdx.x == 0) {
        unsigned* bar = b.bar;
        __builtin_amdgcn_s_waitcnt(0);
        unsigned nloc = b.st[0], nx = b.st[1];
        if (nloc == 0u) { xcd_barrier_complete(bar, b.x, nloc, nx); b.st[0] = nloc; b.st[1] = nx; }
        const unsigned old = xb_add(&bar[XB_XSUB(b.x)], 1u);
        const unsigned gen = old / nloc;
        if (old + 1u == (gen + 1u) * nloc) {
            __builtin_amdgcn_fence(__ATOMIC_RELEASE, "agent");
            asm volatile("s_waitcnt vmcnt(0)" ::: "memory");
            const unsigned og = xb_add(&bar[XB_TOP], 1u);
            const unsigned tg = og / nx;
            if (og + 1u == (tg + 1u) * nx) xb_add(&bar[XB_TOPGEN], 1u);
            else XB_SPIN(xb_ld(&bar[XB_TOPGEN]) == tg, bar);
            __builtin_amdgcn_fence(__ATOMIC_ACQUIRE, "agent");
            xb_add(&bar[XB_XGEN(b.x)], 1u);
            asm volatile("s_waitcnt vmcnt(0)" ::: "memory");
        } else {
            XB_SPIN(xb_ld(&bar[XB_XGEN(b.x)]) == gen, bar);
            __builtin_amdgcn_fence(__ATOMIC_ACQUIRE, "agent");
            asm volatile("s_waitcnt vmcnt(0)" ::: "memory");
        }
    }
    __syncthreads();
}

constexpr int D = 2048, M = 8192, MP = 4096, FF = 8192, NQKV = 3072, RGW = 4096;
constexpr int NL = 4;
constexpr float EPS = 1e-6f;
constexpr int NWAVES = 8, NTHR = 512;
constexpr int OUT_ST = 2 * MP * D;
constexpr int OUT_CK = OUT_ST + 16 * 2 * 2 * 2048;
constexpr int OUT_CV = OUT_CK + 16 * 2 * 256 * 512;
constexpr int OUT_TOTAL = OUT_CV + 16 * 2 * 256 * 512;
enum { I_XP = 0, I_XS, I_STATE, I_CK, I_CV, I_C, I_CCTX, I_WMOD, I_BMOD, I_GPREMIX, I_GPOSTMIX, I_GPREFFN, I_GPOSTFFN, I_WQKV, I_GQ, I_GK, I_WO,
       I_WRGIN, I_CONVW, I_CONVB, I_WRGA, I_BRGA, I_WRGX, I_BRGX, I_LAM, I_WRGOUT, I_WFF1, I_WFF2, N_IN };

constexpr size_t MiB = 1u << 20;
constexpr size_t WS_CTL = 0, CTL_ZERO_BYTES = 1 * MiB;
constexpr size_t WS_MODP = 2 * MiB;
constexpr size_t WS_MODF = 5 * MiB;
constexpr size_t WS_ROPE = 6 * MiB;
constexpr size_t WS_W1T = 8 * MiB;
constexpr size_t WS_W2T = 136 * MiB;
constexpr size_t WS_WQKVT = 264 * MiB;
constexpr size_t WS_WOT = 288 * MiB;
constexpr size_t WS_WRGINT = 304 * MiB;
constexpr size_t WS_WRGOUTT = 336 * MiB;
constexpr size_t WS_XN = 352 * MiB;
constexpr size_t WS_BR = 384 * MiB;
constexpr size_t WS_H = 448 * MiB;
constexpr size_t WS_QKV = 576 * MiB;
constexpr size_t WS_QB = 672 * MiB;
constexpr size_t WS_MIX = 704 * MiB;
constexpr size_t WS_KP = 736 * MiB, WS_VP = 740 * MiB;
constexpr size_t WS_KS = 744 * MiB, WS_VS = 754 * MiB;
constexpr size_t WS_GATE = 764 * MiB;
constexpr size_t WS_XB = 796 * MiB;
constexpr size_t WS_HF = 860 * MiB;
constexpr size_t WS_XR = 892 * MiB;
constexpr size_t WS_DUMMY = 924 * MiB;
constexpr size_t WS_END = 924 * MiB + (MK_REP_POST > 1 ? 96 * MiB : 0);
constexpr size_t WS_NXC = WS_H, WS_NAF = WS_H + 64 * MiB, WS_NUF = WS_QKV, WS_NAB = WS_QKV + 64 * MiB, WS_NUB = WS_BR;

constexpr int LDS_BYTES = 147456;
constexpr int LDSCTL_OFF = LDS_BYTES - 512;

constexpr int NPH = 3 + 10 * NL;
__host__ __device__ inline bool phase_active(int p) {
    if (p < 3) return true;
    const int l = (p - 3) / 10, s = (p - 3) % 10; const bool rg = (l & 1) == 0;
    if (s == 1) return !rg || MK_NAIVE_RG;
    if (s == 3 || s == 4) return rg && MK_NAIVE_RG;
    return true;
}

struct Args { const float* in[N_IN]; float* out; unsigned char* ws; int ph_lo, ph_hi; };
#define PH_LOCALS unsigned char* const ws = a.ws + zz; float* const out = a.out + zz; (void)ws; (void)out

__device__ __forceinline__ float wave_sum(float v) {
#pragma unroll
    for (int o = 1; o < 64; o <<= 1) v += __shfl_xor(v, o);
    return v;
}
__device__ __forceinline__ int mod_idx(int row) { return row < MP ? 0 : 1 + ((row - MP) >> 11); }
__device__ __forceinline__ unsigned long long pack4(f32x4 v) { return (unsigned long long)pg8::cvt_pk_bf16(v.x, v.y) | ((unsigned long long)pg8::cvt_pk_bf16(v.z, v.w) << 32); }
__device__ __forceinline__ v4u pack8(f32x4 a, f32x4 b) { v4u w; w.x = pg8::cvt_pk_bf16(a.x, a.y); w.y = pg8::cvt_pk_bf16(a.z, a.w); w.z = pg8::cvt_pk_bf16(b.x, b.y); w.w = pg8::cvt_pk_bf16(b.z, b.w); return w; }
__device__ __forceinline__ float bf2f(unsigned short b) { return __builtin_bit_cast(float, (unsigned)b << 16); }
__device__ __forceinline__ float sigmoid_f(float x) { return __builtin_amdgcn_rcpf(1.0f + __builtin_amdgcn_exp2f(-1.4426950408889634f * x)); }

__device__ __forceinline__ void p0_transpose_item(const float* W, int K, int N, bf16* WT, LAS float* scr, int item, int lane) {
    const int nblk = N / 32, kb = item / nblk, nb = item % nblk, k0 = 64 * kb, n0 = 32 * nb;
#pragma unroll 8
    for (int i = 0; i < 32; ++i) { const int kk = 2 * i + (lane >> 5); scr[kk * 33 + (lane & 31)] = W[(size_t)(k0 + kk) * N + n0 + (lane & 31)]; }
    LDS_WAIT(); asm volatile("" ::: "memory");
    const int c = lane & 7;
#pragma unroll
    for (int j = 0; j < 4; ++j) { const int n = (lane >> 3) + 8 * j; const LAS float* s = scr + (8 * c) * 33 + n;
        v4u o; o.x = pk2(s[0 * 33], s[1 * 33]); o.y = pk2(s[2 * 33], s[3 * 33]); o.z = pk2(s[4 * 33], s[5 * 33]); o.w = pk2(s[6 * 33], s[7 * 33]);
        *(GAS v4u*)(WT + (size_t)(n0 + n) * K + k0 + 8 * c) = o; }
    LDS_WAIT(); asm volatile("" ::: "memory");
}
__constant__ float INV_FREQ[32] = {1.f, 0.749894261f, 0.562341332f, 0.421696514f, 0.316227764f, 0.237137377f, 0.177827939f, 0.133352131f, 0.100000001f, 0.0749894157f, 0.0562341325f, 0.0421696529f,
    0.0316227749f, 0.0237137377f, 0.0177827943f, 0.0133352149f, 0.00999999978f, 0.00749894185f, 0.00562341325f, 0.00421696482f, 0.00316227763f, 0.00237137359f, 0.00177827943f, 0.00133352145f,
    0.00100000005f, 0.000749894243f, 0.000562341302f, 0.000421696517f, 0.000316227757f, 0.00023713737f, 0.00017782794f, 0.00013335215f};
__device__ __forceinline__ void sincos_d(double a, double& s, double& c) {
    const double k = __builtin_rint(a * 0.6366197723675814);
    double r = __builtin_fma(-k, 1.5707963267948966, a); r = __builtin_fma(-k, 6.123233995736766e-17, r);
    const double r2 = r * r;
    double sp = -7.647163731819816e-13; sp = sp * r2 + 1.6059043836821613e-10; sp = sp * r2 - 2.505210838544172e-08; sp = sp * r2 + 2.7557319223985893e-06; sp = sp * r2 - 1.984126984126984e-04;
    sp = sp * r2 + 8.333333333333333e-03; sp = sp * r2 - 1.6666666666666666e-01; sp = r + r * r2 * sp;
    double cp = 4.779477332387385e-14; cp = cp * r2 - 1.1470745597729725e-11; cp = cp * r2 + 2.08767569878681e-09; cp = cp * r2 - 2.755731922398589e-07; cp = cp * r2 + 2.48015873015873e-05;
    cp = cp * r2 - 1.388888888888889e-03; cp = cp * r2 + 4.1666666666666664e-02; cp = cp * r2 - 0.5; cp = 1.0 + r2 * cp;
    const int q = (int)k & 3;
    s = (q == 0) ? sp : (q == 1) ? cp : (q == 2) ? -sp : -cp;
    c = (q == 0) ? cp : (q == 1) ? -sp : (q == 2) ? -cp : sp;
}
__device__ __forceinline__ void ph_prologue(const Args& a, int zz, LAS unsigned char* lds, int tid, int lane, int wave, int G) {
    PH_LOCALS;
    for (int rept_ = 0; rept_ < MK_REP_PRO_T; ++rept_) {
        const int n4 = tid & 31, wv = tid >> 5;
        struct Desc { const float* W; bf16* WT; int K, N, k0, n0; };
        f32x4 RA[2][8], RB[2][8]; Desc dA{nullptr, nullptr, 0, 0, 0, 0}, dB = dA;
#define P0_DESC(d, it_) do { int r_; const int it__ = (it_); \
            if (it__ < 2048)      { r_ = it__;        const int l_ = r_ >> 9; r_ &= 511; d.W = a.in[zz + I_WFF1] + (size_t)l_ * 2048 * 8192; d.K = 2048; d.N = 8192; d.WT = (bf16*)(ws + WS_W1T) + (size_t)l_ * 8192 * 2048; } \
            else if (it__ < 4096) { r_ = it__ - 2048; const int l_ = r_ >> 9; r_ &= 511; d.W = a.in[zz + I_WFF2] + (size_t)l_ * 8192 * 2048; d.K = 8192; d.N = 2048; d.WT = (bf16*)(ws + WS_W2T) + (size_t)l_ * 2048 * 8192; } \
            else if (it__ < 4480) { r_ = it__ - 4096; const int j_ = r_ / 192; r_ -= j_ * 192; d.W = a.in[zz + I_WQKV] + (size_t)j_ * 2048 * 3072; d.K = 2048; d.N = 3072; d.WT = (bf16*)(ws + WS_WQKVT) + (size_t)j_ * 3072 * 2048; } \
            else if (it__ < 4736) { r_ = it__ - 4480; const int j_ = r_ >> 7; r_ &= 127; d.W = a.in[zz + I_WO] + (size_t)j_ * 2048 * 2048; d.K = 2048; d.N = 2048; d.WT = (bf16*)(ws + WS_WOT) + (size_t)j_ * 2048 * 2048; } \
            else if (it__ < 5248) { r_ = it__ - 4736; const int j_ = r_ >> 8; r_ &= 255; d.W = a.in[zz + I_WRGIN] + (size_t)j_ * 2048 * 4096; d.K = 2048; d.N = 4096; d.WT = (bf16*)(ws + WS_WRGINT) + (size_t)j_ * 4096 * 2048; } \
            else                  { r_ = it__ - 5248; const int j_ = r_ >> 7; r_ &= 127; d.W = a.in[zz + I_WRGOUT] + (size_t)j_ * 2048 * 2048; d.K = 2048; d.N = 2048; d.WT = (bf16*)(ws + WS_WRGOUTT) + (size_t)j_ * 2048 * 2048; } \
            const int nblk_ = d.N >> 7, kb_ = r_ / nblk_, nb_ = r_ - kb_ * nblk_; d.k0 = 256 * kb_; d.n0 = 128 * nb_; } while (0)
#define P0_LOAD(R, d) do { _Pragma("unroll") for (int i = 0; i < 2; ++i) _Pragma("unroll") for (int e = 0; e < 8; ++e) \
            R[i][e] = __builtin_nontemporal_load((const f32x4*)(d.W + (size_t)(d.k0 + 8 * (wv + 16 * i) + e) * d.N + d.n0 + 4 * n4)); } while (0)
#define P0_ITEM(R, d, itv, buf) do { LAS unsigned char* img = lds + (buf) * 65536; \
            _Pragma("unroll") for (int i = 0; i < 2; ++i) _Pragma("unroll") for (int c = 0; c < 4; ++c) { const int row = 4 * n4 + c, chunk = (wv + 16 * i) ^ (n4 & 31); \
                v4u w; w.x = pg8::cvt_pk_bf16(R[i][0][c], R[i][1][c]); w.y = pg8::cvt_pk_bf16(R[i][2][c], R[i][3][c]); w.z = pg8::cvt_pk_bf16(R[i][4][c], R[i][5][c]); w.w = pg8::cvt_pk_bf16(R[i][6][c], R[i][7][c]); \
                *(LAS v4u*)(img + row * 512 + chunk * 16) = w; } \
            __syncthreads(); \
            bf16* WTc = d.WT; const int Kc = d.K, k0c = d.k0, n0c = d.n0; const bool valid_ = (itv) < 5504; \
            { const int nit_ = (itv) + 2 * G; P0_DESC(d, nit_ < 5504 ? nit_ : 5503); P0_LOAD(R, d); }     \
            if (valid_) { _Pragma("unroll") for (int rr = 0; rr < 8; ++rr) { const int row = rr * 16 + (tid >> 5), jp = tid & 31, j = jp ^ ((row >> 2) & 31); \
                const v4u v = *(const LAS v4u*)(img + row * 512 + jp * 16); \
                __builtin_nontemporal_store(v, (v4u*)(WTc + (size_t)(n0c + row) * Kc + k0c + 8 * j)); } } } while (0)
        int it = blockIdx.x;
        { P0_DESC(dA, it < 5504 ? it : 5503); P0_LOAD(RA, dA); }
        { P0_DESC(dB, it + G < 5504 ? it + G : 5503); P0_LOAD(RB, dB); }
        while (it < 5504) {
            P0_ITEM(RA, dA, it, 0);
            P0_ITEM(RB, dB, it + G, 1);
            it += 2 * G;
        }
        asm volatile("s_waitcnt vmcnt(0)" ::: "memory");
#undef P0_DESC
#undef P0_LOAD
#undef P0_ITEM
    }
    __syncthreads();
    for (int repg_ = 0; repg_ < MK_REP_PRO_G; ++repg_) {
        LAS float* S = (LAS float*)lds;
        LAS float* red = (LAS float*)(lds + 24576);
        for (int i = tid; i < 3 * 2048; i += NTHR) { const int ci = i >> 11, k = i & 2047; const float x = ci == 0 ? a.in[zz + I_CCTX][k] : a.in[zz + I_C][(ci - 1) * 2048 + k]; S[i] = x * sigmoid_f(x); }
        __syncthreads();
        float* MODP = (float*)(ws + WS_MODP);
        for (int bi = blockIdx.x; bi < 768; bi += G) {
            const int l = bi / 192, rem = bi % 192, cc = rem >> 2, kg = rem & 3, k0 = kg * 512 + wave * 64;
            const float* wp = a.in[zz + I_WMOD] + ((size_t)l * 2048 + k0) * 12288 + cc * 256 + lane * 4;
            f32x4 a0 = {0.f, 0.f, 0.f, 0.f}, a1 = a0, a2 = a0;
            f32x4 wq[2][16];
#pragma unroll
            for (int e = 0; e < 16; ++e) wq[0][e] = __builtin_nontemporal_load((const f32x4*)(wp + (size_t)e * 12288));
#pragma unroll
            for (int c4 = 0; c4 < 4; ++c4) {
                if (c4 < 3) {
#pragma unroll
                    for (int e = 0; e < 16; ++e) wq[(c4 + 1) & 1][e] = __builtin_nontemporal_load((const f32x4*)(wp + (size_t)(16 * (c4 + 1) + e) * 12288)); }
#pragma unroll
                for (int e = 0; e < 16; ++e) { const int kk = 16 * c4 + e; const f32x4 w = wq[c4 & 1][e];
                    const float s0 = S[k0 + kk], s1 = S[2048 + k0 + kk], s2 = S[4096 + k0 + kk]; a0 += w * s0; a1 += w * s1; a2 += w * s2; }
            }
            *(LAS f32x4*)(red + (wave * 3 + 0) * 256 + lane * 4) = a0; *(LAS f32x4*)(red + (wave * 3 + 1) * 256 + lane * 4) = a1; *(LAS f32x4*)(red + (wave * 3 + 2) * 256 + lane * 4) = a2;
            __syncthreads();
            for (int e = tid; e < 768; e += NTHR) { const int i = e >> 8, col = e & 255; float s = 0.f;
#pragma unroll
                for (int w = 0; w < 8; ++w) s += red[(w * 3 + i) * 256 + col];
                MODP[((size_t)(kg * 4 + l) * 3 + i) * 12288 + cc * 256 + col] = s; }
            __syncthreads();
        }
    }
    {
        const int gtid = blockIdx.x * NTHR + tid, NGT = G * NTHR;
        for (int t = gtid; t < 2 * 131072; t += NGT) {
            const int kv = t >> 17, e = (t & 131071) * 8;
            const int b = e >> 19, j = (e >> 18) & 1, p = (e >> 9) & 511, c = e & 511;
            const float* src = (kv ? a.in[zz + I_CV] : a.in[zz + I_CK]) + e;
            const f32x4 v0 = *(const f32x4*)src, v1 = *(const f32x4*)(src + 4);
            bf16* dst = (bf16*)(ws + (kv ? WS_VS : WS_KS)) + ((size_t)(j * 2 + b) * 2560 + 2048 + p) * 512 + c;
            *(v4u*)dst = pack8(v0, v1);
        }
        if (gtid < 2048) { const int pos = gtid >> 5, p = gtid & 31; const float ang = (float)pos * INV_FREQ[p]; double s, c; sincos_d((double)ang, s, c);
            float* R = (float*)(ws + WS_ROPE); R[gtid] = (float)c; R[2048 + gtid] = (float)s; }
    }
}
__device__ __forceinline__ void ph_modreduce(const Args& a, int zz, int tid, int G) {
    PH_LOCALS;
    const float* MODP = (const float*)(ws + WS_MODP); float* MODF = (float*)(ws + WS_MODF);
    const int gtid = blockIdx.x * NTHR + tid, NGT = G * NTHR;
    for (int e = gtid; e < 4 * 3 * 12288; e += NGT) {
        const int n = e % 12288, li = e / 12288, l = li / 3, q = n >> 11, c = n & 2047;
        float m = a.in[zz + I_BMOD][l * 12288 + n];
#pragma unroll
        for (int kg = 0; kg < 4; ++kg) m += MODP[((size_t)(kg * 4 + l) * 3 + (li - l * 3)) * 12288 + n];
        float v = m;
        if (q == 1) v = a.in[zz + I_GPREMIX][l * 2048 + c] * (1.f + m);
        else if (q == 2) v = a.in[zz + I_GPOSTMIX][l * 2048 + c] * m;
        else if (q == 4) v = a.in[zz + I_GPREFFN][l * 2048 + c] * (1.f + m);
        else if (q == 5) v = a.in[zz + I_GPOSTFFN][l * 2048 + c] * m;
        MODF[(size_t)li * 12288 + n] = v;
    }
}
__device__ __forceinline__ const float* modf_vec(const unsigned char* ws, int l, int idx, int q) { return (const float*)(ws + WS_MODF) + ((size_t)(l * 3 + idx) * 6 + q) * 2048; }
__device__ __forceinline__ void ph_pre0(const Args& a, int zz, int lane, int wave, int G) {
    PH_LOCALS;
    const int gw = blockIdx.x * NWAVES + wave, NGW = G * NWAVES;
    bf16* XN = (bf16*)(ws + WS_XN);
    for (int task = gw; task < M / 4; task += NGW) {
        const int row0 = task * 4, idx = mod_idx(row0);
        const f32x4* Sv = (const f32x4*)modf_vec(ws, 0, idx, 1) + lane; const f32x4* Bv = (const f32x4*)modf_vec(ws, 0, idx, 0) + lane;
        f32x4 S[8], B[8];
#pragma unroll
        for (int j = 0; j < 8; ++j) { S[j] = Sv[64 * j]; B[j] = Bv[64 * j]; }
#pragma unroll 1
        for (int r = 0; r < 4; ++r) {
            const int row = row0 + r;
            const f32x4* xr = (const f32x4*)(row < MP ? a.in[zz + I_XP] + (size_t)row * D : a.in[zz + I_XS] + (size_t)(row - MP) * D) + lane;
            f32x4 v[8]; float ss = 0.f;
#pragma unroll
            for (int j = 0; j < 8; ++j) { v[j] = xr[64 * j]; ss += (v[j].x * v[j].x + v[j].y * v[j].y) + (v[j].z * v[j].z + v[j].w * v[j].w); }
            const float rs = rsqrtf(wave_sum(ss) * (1.f / D) + EPS);
            unsigned long long* o8 = (unsigned long long*)(XN + (size_t)row * D) + lane;
#pragma unroll
            for (int j = 0; j < 8; ++j) o8[64 * j] = pack4(v[j] * rs * S[j] + B[j]);
        }
    }
}
__device__ __forceinline__ void ph_post(const Args& a, int zz, int l, int which, int lane, int wave, int G, bool dry = false) {
    PH_LOCALS;
    float* const xout = dry ? (float*)(ws + WS_DUMMY) : out; (void)xout;
    const int gw = blockIdx.x * NWAVES + wave, NGW = G * NWAVES;
    const bool has_next = (which == 0) || (l < NL - 1);
    const int ln = which == 0 ? l : l + 1, qG = which == 0 ? 2 : 5, qS = which == 0 ? 4 : 1, qB = which == 0 ? 3 : 0;
    const bool first = (l == 0 && which == 0);
    const bool last = (l == NL - 1 && which == 1);
    const bf16* XR = (const bf16*)(ws + WS_XR); bf16* XRo = dry ? (bf16*)(ws + WS_DUMMY) : (bf16*)(ws + WS_XR);
    const bf16* BR = (const bf16*)(ws + WS_BR); bf16* XN = dry ? (bf16*)(ws + WS_DUMMY + 64 * MiB) : (bf16*)(ws + WS_XN);
    for (int task = gw; task < M / 4; task += NGW) {
        const int row0 = task * 4, idx = mod_idx(row0);
        f32x4 Gv[8];
        { const f32x4* p = (const f32x4*)modf_vec(ws, l, idx, qG) + lane;
#pragma unroll
          for (int j = 0; j < 8; ++j) Gv[j] = p[64 * j]; }
        const f32x4* ps = (const f32x4*)modf_vec(ws, has_next ? ln : l, idx, qS) + lane; const f32x4* pb = (const f32x4*)modf_vec(ws, has_next ? ln : l, idx, qB) + lane;
#pragma unroll 1
        for (int rp = 0; rp < 2; ++rp) {
            unsigned long long vr[2][8]; f32x4 x[2][8];
#pragma unroll
            for (int r = 0; r < 2; ++r) {
                const int row = row0 + 2 * rp + r;
                const unsigned long long* br = (const unsigned long long*)(BR + (size_t)row * D) + lane;
#pragma unroll
                for (int j = 0; j < 8; ++j) vr[r][j] = __builtin_nontemporal_load(br + 64 * j);
                if (first) {
                    const f32x4* xr = (const f32x4*)(row < MP ? a.in[zz + I_XP] + (size_t)row * D : a.in[zz + I_XS] + (size_t)(row - MP) * D) + lane;
#pragma unroll
                    for (int j = 0; j < 8; ++j) x[r][j] = __builtin_nontemporal_load(xr + 64 * j);
                } else {
                    const unsigned long long* xr = (const unsigned long long*)(XR + (size_t)row * D) + lane;
#pragma unroll
                    for (int j = 0; j < 8; ++j) { const unsigned long long w = __builtin_nontemporal_load(xr + 64 * j); const unsigned lo = (unsigned)w, hi = (unsigned)(w >> 32);
                        x[r][j].x = __builtin_bit_cast(float, lo << 16); x[r][j].y = __builtin_bit_cast(float, lo & 0xffff0000u); x[r][j].z = __builtin_bit_cast(float, hi << 16); x[r][j].w = __builtin_bit_cast(float, hi & 0xffff0000u); }
                }
            }
#pragma unroll
            for (int r = 0; r < 2; ++r) {
                const int row = row0 + 2 * rp + r;
                f32x4 v[8]; float ss = 0.f;
#pragma unroll
                for (int j = 0; j < 8; ++j) { const unsigned lo = (unsigned)vr[r][j], hi = (unsigned)(vr[r][j] >> 32);
                    v[j].x = __builtin_bit_cast(float, lo << 16); v[j].y = __builtin_bit_cast(float, lo & 0xffff0000u); v[j].z = __builtin_bit_cast(float, hi << 16); v[j].w = __builtin_bit_cast(float, hi & 0xffff0000u);
                    ss += (v[j].x * v[j].x + v[j].y * v[j].y) + (v[j].z * v[j].z + v[j].w * v[j].w); }
                const float rs = rsqrtf(wave_sum(ss) * (1.f / D) + EPS);
                f32x4* xo = (f32x4*)(xout + (size_t)row * D) + lane; unsigned long long* xo16 = (unsigned long long*)(XRo + (size_t)row * D) + lane; float s2 = 0.f;
#pragma unroll
                for (int j = 0; j < 8; ++j) { const f32x4 xn = x[r][j] + Gv[j] * (v[j] * rs); x[r][j] = xn;
                    if (last) __builtin_nontemporal_store(xn, xo + 64 * j); else __builtin_nontemporal_store(pack4(xn), xo16 + 64 * j);
                    s2 += (xn.x * xn.x + xn.y * xn.y) + (xn.z * xn.z + xn.w * xn.w); }
                if (has_next) {
                    const float rs2 = rsqrtf(wave_sum(s2) * (1.f / D) + EPS);
                    unsigned long long* o8 = (unsigned long long*)(XN + (size_t)row * D) + lane;
#pragma unroll
                    for (int j = 0; j < 8; ++j) o8[64 * j] = pack4(x[r][j] * rs2 * ps[64 * j] + pb[64 * j]);
                }
            }
        }
    }
}
__device__ __forceinline__ void ph_qknorm(const Args& a, int zz, int j, int lane, int wave, int G) {
    PH_LOCALS;
    const int gw = blockIdx.x * NWAVES + wave, NGW = G * NWAVES;
    const int hq = lane >> 4, q16 = lane & 15;
    const bf16* QKV = (const bf16*)(ws + WS_QKV); const float* ROPE = (const float*)(ws + WS_ROPE);
    bf16* QB = (bf16*)(ws + WS_QB); bf16* KP = (bf16*)(ws + WS_KP); bf16* VP = (bf16*)(ws + WS_VP);
    bf16* KSj = (bf16*)(ws + WS_KS) + (size_t)j * 2 * 2560 * 512; bf16* VSj = (bf16*)(ws + WS_VS) + (size_t)j * 2 * 2560 * 512;
    const f32x4 gq0 = *(const f32x4*)(a.in[zz + I_GQ] + j * 128 + q16 * 8), gq1 = *(const f32x4*)(a.in[zz + I_GQ] + j * 128 + q16 * 8 + 4);
    const f32x4 gk0 = *(const f32x4*)(a.in[zz + I_GK] + j * 128 + q16 * 8), gk1 = *(const f32x4*)(a.in[zz + I_GK] + j * 128 + q16 * 8 + 4);
    const float sgn = (q16 & 4) ? 1.f : -1.f;
    for (int row = gw; row < M; row += NGW) {
        const bool samp = row >= MP; const int b = samp ? (row - MP) >> 11 : row >> 8, t = samp ? (row - MP) & 2047 : row & 255;
        f32x4 c0 = {1.f, 1.f, 1.f, 1.f}, c1 = c0, s0 = {0.f, 0.f, 0.f, 0.f}, s1 = s0;
        if (samp) { const int pos = (q16 < 8) ? (t >> 6) : (t & 63); const float* rp = ROPE + pos * 32 + 8 * (q16 & 3);
            c0 = *(const f32x4*)rp; c1 = *(const f32x4*)(rp + 4); s0 = *(const f32x4*)(rp + 2048); s1 = *(const f32x4*)(rp + 2052); }
#pragma unroll
        for (int it = 0; it < 6; ++it) {
            const v4u raw = *(const v4u*)(QKV + (size_t)row * NQKV + it * 512 + hq * 128 + q16 * 8);
            f32x4 v0, v1; v0.x = __builtin_bit_cast(float, raw.x << 16); v0.y = __builtin_bit_cast(float, raw.x & 0xffff0000u); v0.z = __builtin_bit_cast(float, raw.y << 16); v0.w = __builtin_bit_cast(float, raw.y & 0xffff0000u);
            v1.x = __builtin_bit_cast(float, raw.z << 16); v1.y = __builtin_bit_cast(float, raw.z & 0xffff0000u); v1.z = __builtin_bit_cast(float, raw.w << 16); v1.w = __builtin_bit_cast(float, raw.w & 0xffff0000u);
            if (it < 5) {
                float ss = (v0.x * v0.x + v0.y * v0.y) + (v0.z * v0.z + v0.w * v0.w) + (v1.x * v1.x + v1.y * v1.y) + (v1.z * v1.z + v1.w * v1.w);
                ss += __shfl_xor(ss, 1); ss += __shfl_xor(ss, 2); ss += __shfl_xor(ss, 4); ss += __shfl_xor(ss, 8);
                const float rs = rsqrtf(ss * (1.f / 128.f) + EPS);
                v0 = v0 * rs * (it < 4 ? gq0 : gk0); v1 = v1 * rs * (it < 4 ? gq1 : gk1);
                if (samp) {
                    f32x4 p0, p1;
                    p0.x = __shfl_xor(v0.x, 4); p0.y = __shfl_xor(v0.y, 4); p0.z = __shfl_xor(v0.z, 4); p0.w = __shfl_xor(v0.w, 4);
                    p1.x = __shfl_xor(v1.x, 4); p1.y = __shfl_xor(v1.y, 4); p1.z = __shfl_xor(v1.z, 4); p1.w = __shfl_xor(v1.w, 4);
                    v0 = v0 * c0 + (p0 * s0) * sgn; v1 = v1 * c1 + (p1 * s1) * sgn;
                }
            }
            const v4u pk = pack8(v0, v1);
            if (it < 4) *(v4u*)(QB + (size_t)row * D + it * 512 + hq * 128 + q16 * 8) = pk;
            else {
                bf16* dstS = (it == 4 ? KSj : VSj) + ((size_t)b * 2560 + t) * 512 + hq * 128 + q16 * 8;
                bf16* dstP = (it == 4 ? KP : VP) + (size_t)row * 512 + hq * 128 + q16 * 8;
                if (samp) *(v4u*)dstS = pk;
                else { *(v4u*)dstP = pk; float* o = out + (it == 4 ? OUT_CK : OUT_CV) + ((size_t)(b * 2 + j) * 256 + t) * 512 + hq * 128 + q16 * 8; __builtin_nontemporal_store(v0, (f32x4*)o); __builtin_nontemporal_store(v1, (f32x4*)(o + 4)); }
            }
        }
    }
}

__device__ __forceinline__ float rg_coef(float lam) {
    const float x = __expf(-lam);
    const float l1p = (x < 0.05f) ? x * (1.f + x * (-0.5f + x * (0.33333333f + x * (-0.25f + x * (0.2f + x * (-0.16666667f)))))) : __logf(1.f + x);
    return -8.0f * l1p;
}
__device__ __forceinline__ void rg_elem(float racc, float iacc, float coef, float xc, float& a, float& u) {
    const float r = sigmoid_f(racc), ig = sigmoid_f(iacc), la = coef * r;
    a = __builtin_amdgcn_exp2f(1.4426950408889634f * la);
    const float z = 2.f * la;
    const float poly = -z * (1.f + z * (0.5f + z * (0.16666667f + z * (0.041666668f + z * 0.0083333338f)))), big = 1.f - a * a;
    const float sel = (z > -0.1f) ? 1.f : 0.f; const float m1 = big + sel * (poly - big);
    u = __builtin_amdgcn_sqrtf(m1) * ig * xc;
}
__device__ __forceinline__ void seq_bounds(int row, int& s0, int& T) { if (row < MP) { s0 = row & ~255; T = 256; } else { s0 = MP + ((row - MP) & ~2047); T = 2048; } }

#if MK_NAIVE_RG
__device__ __forceinline__ void ph_rg_conv_naive(const Args& a, int zz, int jl, int tid, int G) {
    PH_LOCALS;
    const int gtid = blockIdx.x * NTHR + tid, NGT = G * NTHR;
    const bf16* XB = (const bf16*)(ws + WS_XB); float* XC = (float*)(ws + WS_NXC);
    const float* cw = a.in[zz + I_CONVW] + (size_t)jl * 4 * 2048; const float* cb = a.in[zz + I_CONVB] + (size_t)jl * 2048;
    for (int task = gtid; task < M * 512; task += NGT) {
        const int row = task >> 9, c4 = (task & 511) * 4; int s0, T; seq_bounds(row, s0, T);
        f32x4 acc = *(const f32x4*)(cb + c4);
#pragma unroll
        for (int k = 0; k < 4; ++k) { const int r2 = row + k - 1; if (r2 >= s0 && r2 < s0 + T) { const unsigned long long xv = *(const unsigned long long*)(XB + (size_t)r2 * 2048 + c4); const unsigned lo = (unsigned)xv, hi = (unsigned)(xv >> 32); f32x4 xf; xf.x = __builtin_bit_cast(float, lo << 16); xf.y = __builtin_bit_cast(float, lo & 0xffff0000u); xf.z = __builtin_bit_cast(float, hi << 16); xf.w = __builtin_bit_cast(float, hi & 0xffff0000u); acc += *(const f32x4*)(cw + k * 2048 + c4) * xf; } }
        *(f32x4*)(XC + (size_t)row * 2048 + c4) = acc;
    }
}
__device__ __forceinline__ void ph_rg_gates_naive(const Args& a, int zz, int jl, int tid, int G) {
    PH_LOCALS;
    const int gtid = blockIdx.x * NTHR + tid, NGT = G * NTHR;
    const float* XC = (const float*)(ws + WS_NXC);
    float* AF = (float*)(ws + WS_NAF); float* UF = (float*)(ws + WS_NUF); float* AB = (float*)(ws + WS_NAB); float* UB = (float*)(ws + WS_NUB);
    for (int task = gtid; task < M * 2048; task += NGT) {
        const int row = task >> 11, ch = task & 2047, n = ch >> 7, k = ch & 127;
        const float* xc = XC + (size_t)row * 2048 + n * 128;
        const float* wa0 = a.in[zz + I_WRGA] + ((size_t)((jl * 2 + 0) * 16 + n) * 128) * 128 + k; const float* wa1 = a.in[zz + I_WRGA] + ((size_t)((jl * 2 + 1) * 16 + n) * 128) * 128 + k;
        const float* wx0 = a.in[zz + I_WRGX] + ((size_t)((jl * 2 + 0) * 16 + n) * 128) * 128 + k; const float* wx1 = a.in[zz + I_WRGX] + ((size_t)((jl * 2 + 1) * 16 + n) * 128) * 128 + k;
        float r0 = 0.f, r1 = 0.f, i0 = 0.f, i1 = 0.f;
#pragma unroll 8
        for (int j = 0; j < 128; ++j) { const float x = xc[j]; r0 += x * wa0[j * 128]; r1 += x * wa1[j * 128]; i0 += x * wx0[j * 128]; i1 += x * wx1[j * 128]; }
        const float xv = xc[k];
        float av, uv;
        rg_elem(r0 + a.in[zz + I_BRGA][(jl * 2 + 0) * 2048 + ch], i0 + a.in[zz + I_BRGX][(jl * 2 + 0) * 2048 + ch], rg_coef(a.in[zz + I_LAM][(jl * 2 + 0) * 2048 + ch]), xv, av, uv);
        AF[task] = av; UF[task] = uv;
        rg_elem(r1 + a.in[zz + I_BRGA][(jl * 2 + 1) * 2048 + ch], i1 + a.in[zz + I_BRGX][(jl * 2 + 1) * 2048 + ch], rg_coef(a.in[zz + I_LAM][(jl * 2 + 1) * 2048 + ch]), xv, av, uv);
        AB[task] = av; UB[task] = uv;
    }
}
__device__ __forceinline__ void ph_rg_scan_naive(const Args& a, int zz, int jl, int tid, int G) {
    PH_LOCALS;
    const int gtid = blockIdx.x * NTHR + tid, NGT = G * NTHR;
    for (int task = gtid; task < 18 * 2 * 2048; task += NGT) {
        const int sq = task >> 12, dir = (task >> 11) & 1, ch = task & 2047;
        int row0, T; float h;
        if (sq < 16) { row0 = sq * 256; T = 256; h = 0.f; } else { row0 = MP + (sq - 16) * 2048; T = 2048; h = a.in[zz + I_STATE][((size_t)((sq - 16) * 2 + jl) * 2 + dir) * 2048 + ch]; }
        const float* A = (const float*)(ws + (dir ? WS_NAB : WS_NAF)); float* U = (float*)(ws + (dir ? WS_NUB : WS_NUF));
        for (int tt = 0; tt < T; tt += 8) {
            float av[8], uv[8];
#pragma unroll
            for (int e = 0; e < 8; ++e) { const int t = dir ? (T - 1 - tt - e) : (tt + e); av[e] = A[(size_t)(row0 + t) * 2048 + ch]; uv[e] = U[(size_t)(row0 + t) * 2048 + ch]; }
#pragma unroll
            for (int e = 0; e < 8; ++e) { const int t = dir ? (T - 1 - tt - e) : (tt + e); h = av[e] * h + uv[e]; U[(size_t)(row0 + t) * 2048 + ch] = h; }
        }
        if (sq < 16) out[OUT_ST + ((size_t)(sq * 2 + jl) * 2 + dir) * 2048 + ch] = h;
    }
}
__device__ __forceinline__ void ph_rg_y_naive(const Args& a, int zz, int tid, int G) {
    PH_LOCALS;
    const int gtid = blockIdx.x * NTHR + tid, NGT = G * NTHR;
    const float* UF = (const float*)(ws + WS_NUF); const float* UB = (const float*)(ws + WS_NUB); const bf16* GT = (const bf16*)(ws + WS_GATE); bf16* MIX = (bf16*)(ws + WS_MIX);
    for (int task = gtid; task < M * 2048 / 8; task += NGT) {
        const size_t e = (size_t)task * 8;
        const f32x4 f0 = *(const f32x4*)(UF + e), f1 = *(const f32x4*)(UF + e + 4), b0 = *(const f32x4*)(UB + e), b1 = *(const f32x4*)(UB + e + 4);
        const v4u g = *(const v4u*)(GT + e);
        f32x4 g0, g1; g0.x = __builtin_bit_cast(float, g.x << 16); g0.y = __builtin_bit_cast(float, g.x & 0xffff0000u); g0.z = __builtin_bit_cast(float, g.y << 16); g0.w = __builtin_bit_cast(float, g.y & 0xffff0000u);
        g1.x = __builtin_bit_cast(float, g.z << 16); g1.y = __builtin_bit_cast(float, g.z & 0xffff0000u); g1.z = __builtin_bit_cast(float, g.w << 16); g1.w = __builtin_bit_cast(float, g.w & 0xffff0000u);
        *(v4u*)(MIX + e) = pack8((f0 + b0) * g0, (f1 + b1) * g1);
    }
}
#endif

#if MK_NAIVE_ATTN
__device__ __forceinline__ void ph_attn_naive(const Args& a, int zz, int j, int tid, int G) {
    PH_LOCALS;
    const int gtid = blockIdx.x * NTHR + tid, NGT = G * NTHR;
    const bf16* QB = (const bf16*)(ws + WS_QB); bf16* OB = (bf16*)(ws + WS_MIX);
    const bf16* KP = (const bf16*)(ws + WS_KP); const bf16* VP = (const bf16*)(ws + WS_VP);
    const bf16* KSj = (const bf16*)(ws + WS_KS) + (size_t)j * 2 * 2560 * 512; const bf16* VSj = (const bf16*)(ws + WS_VS) + (size_t)j * 2 * 2560 * 512;
    constexpr float C = 0.088388347648318440f * 1.4426950408889634f;
    for (int lt = gtid; lt < M * 64; lt += NGT) {
        const int sub = lt & 3, h = (lt >> 2) & 15, row = lt >> 6, kvh = h >> 2;
        const bf16* Kb; const bf16* Vb; int nk;
        if (row < MP) { const int b = row >> 8; Kb = KP + (size_t)(b * 256) * 512 + kvh * 128 + sub * 32; Vb = VP + (size_t)(b * 256) * 512 + kvh * 128 + sub * 32; nk = 256; }
        else { const int b = (row - MP) >> 11; Kb = KSj + (size_t)(b * 2560) * 512 + kvh * 128 + sub * 32; Vb = VSj + (size_t)(b * 2560) * 512 + kvh * 128 + sub * 32; nk = 2560; }
        float q[32], o[32];
        { const bf16* qp = QB + (size_t)row * D + h * 128 + sub * 32;
#pragma unroll
          for (int d = 0; d < 32; ++d) { q[d] = bf2f(qp[d]) * C; o[d] = 0.f; } }
        float m = -1e30f, l = 0.f;
        for (int kk = 0; kk < nk; ++kk) {
            const v4u* kp = (const v4u*)(Kb + (size_t)kk * 512); const v4u* vp = (const v4u*)(Vb + (size_t)kk * 512);
            float s = 0.f;
#pragma unroll
            for (int c = 0; c < 4; ++c) { const v4u w = kp[c];
                s += q[8 * c + 0] * __builtin_bit_cast(float, w.x << 16) + q[8 * c + 1] * __builtin_bit_cast(float, w.x & 0xffff0000u) + q[8 * c + 2] * __builtin_bit_cast(float, w.y << 16) + q[8 * c + 3] * __builtin_bit_cast(float, w.y & 0xffff0000u)
                   + q[8 * c + 4] * __builtin_bit_cast(float, w.z << 16) + q[8 * c + 5] * __builtin_bit_cast(float, w.z & 0xffff0000u) + q[8 * c + 6] * __builtin_bit_cast(float, w.w << 16) + q[8 * c + 7] * __builtin_bit_cast(float, w.w & 0xffff0000u); }
            s += __shfl_xor(s, 1); s += __shfl_xor(s, 2);
            const float mn = fmaxf(m, s), al = __builtin_amdgcn_exp2f(m - mn), p = __builtin_amdgcn_exp2f(s - mn);
            l = l * al + p; m = mn;
#pragma unroll
            for (int c = 0; c < 4; ++c) { const v4u w = vp[c];
                o[8 * c + 0] = o[8 * c + 0] * al + p * __builtin_bit_cast(float, w.x << 16); o[8 * c + 1] = o[8 * c + 1] * al + p * __builtin_bit_cast(float, w.x & 0xffff0000u);
                o[8 * c + 2] = o[8 * c + 2] * al + p * __builtin_bit_cast(float, w.y << 16); o[8 * c + 3] = o[8 * c + 3] * al + p * __builtin_bit_cast(float, w.y & 0xffff0000u);
                o[8 * c + 4] = o[8 * c + 4] * al + p * __builtin_bit_cast(float, w.z << 16); o[8 * c + 5] = o[8 * c + 5] * al + p * __builtin_bit_cast(float, w.z & 0xffff0000u);
                o[8 * c + 6] = o[8 * c + 6] * al + p * __builtin_bit_cast(float, w.w << 16); o[8 * c + 7] = o[8 * c + 7] * al + p * __builtin_bit_cast(float, w.w & 0xffff0000u); }
        }
        const float il = 1.f / l;
        bf16* op = OB + (size_t)row * D + h * 128 + sub * 32;
#pragma unroll
        for (int c = 0; c < 4; ++c) { f32x4 x0 = {o[8 * c] * il, o[8 * c + 1] * il, o[8 * c + 2] * il, o[8 * c + 3] * il}, x1 = {o[8 * c + 4] * il, o[8 * c + 5] * il, o[8 * c + 6] * il, o[8 * c + 7] * il}; *(v4u*)(op + 8 * c) = pack8(x0, x1); }
    }
}
#endif
namespace attn_body {
using bf16 = __hip_bfloat16;
constexpr int   D = 128, NW = 8, QBLK = 32, KVBLK = 64;
constexpr float SCALE = 0.088388347648318440f;
constexpr float THR = 8.f;
constexpr int SDEPTH = 2;
constexpr int LDQ = 2048, LDK = 512, LDO = 2048;
constexpr size_t SHM_V = KVBLK * D * 2, SHM_K = KVBLK * D * 2, SHM_ATTN = 2 * SHM_V + 2 * SHM_K + NW * 64 * 4;
using bf16x8 = __attribute__((ext_vector_type(8))) short;
using s16x4  = __attribute__((ext_vector_type(4))) short;
using f32x16 = __attribute__((ext_vector_type(16))) float;
using f32x8  = __attribute__((ext_vector_type(8))) float;
using u32x4  = __attribute__((ext_vector_type(4))) unsigned;
#define KSWZ(row, colB) ((row) * 256 + ((colB) ^ (((row) & 7) << 4)))
#define SBAR() __builtin_amdgcn_sched_barrier(0)
__device__ __forceinline__ int crow(int r, int hi) { return (r & 3) + 8 * (r >> 2) + 4 * hi; }
__device__ __forceinline__ unsigned cvtpk(float lo, float hi) {
  unsigned r; asm volatile("v_cvt_pk_bf16_f32 %0, %1, %2" : "=v"(r) : "v"(lo), "v"(hi)); return r;
}
template <typename TIn> struct Stage;
template <> struct Stage<bf16>  { using T = bf16x8;
  __device__ static __forceinline__ T ld8(const bf16* p) { return *reinterpret_cast<const bf16x8*>(p); }
  __device__ static __forceinline__ bf16x8 tobf(T x) { return x; } };
template <> struct Stage<float> { using T = f32x8;
  __device__ static __forceinline__ T ld8(const float* p) { return *reinterpret_cast<const f32x8*>(p); }
  __device__ static __forceinline__ bf16x8 tobf(T x) {
    u32x4 w = {cvtpk(x[0], x[1]), cvtpk(x[2], x[3]), cvtpk(x[4], x[5]), cvtpk(x[6], x[7])}; return *reinterpret_cast<bf16x8*>(&w); } };

__device__ __forceinline__ void partialSM(f32x16& p0, f32x16& p1, float& m_reg, float& mn, float& alpha) {
  constexpr float C = SCALE * 1.4426950408889634f;
  float pmax = p0[0]; for (int r = 1; r < 16; ++r) pmax = fmaxf(pmax, p0[r]); for (int r = 0; r < 16; ++r) pmax = fmaxf(pmax, p1[r]);
  { auto rr = __builtin_amdgcn_permlane32_swap(__float_as_uint(pmax), __float_as_uint(pmax), false, false);
    pmax = fmaxf(__uint_as_float(rr[0]), __uint_as_float(rr[1])); }
  if (__builtin_expect(__all(pmax - m_reg <= THR / SCALE), 1)) { mn = m_reg; alpha = 1.f; }
  else { mn = fmaxf(m_reg, pmax); alpha = __builtin_amdgcn_exp2f((m_reg - mn) * C); m_reg = mn; }
  float mnC = -mn * C;
  for (int r = 0; r < 16; ++r) p0[r] = fmaf(p0[r], C, mnC); for (int r = 0; r < 16; ++r) p1[r] = fmaf(p1[r], C, mnC);
  for (int r = 0; r < 16; ++r) p0[r] = __builtin_amdgcn_exp2f(p0[r]);
}
__device__ __forceinline__ void finishSM(f32x16& p0, f32x16& p1, float alpha, float& l_reg, bf16x8& pa0, bf16x8& pa1, bf16x8& pa2, bf16x8& pa3) {
  for (int r = 0; r < 16; ++r) p1[r] = __builtin_amdgcn_exp2f(p1[r]);
  float ps = 0; for (int r = 0; r < 16; ++r) ps += p0[r]; for (int r = 0; r < 16; ++r) ps += p1[r];
  { auto rr = __builtin_amdgcn_permlane32_swap(__float_as_uint(ps), __float_as_uint(ps), false, false);
    ps = __uint_as_float(rr[0]) + __uint_as_float(rr[1]); }
  l_reg = l_reg * alpha + ps;
#define PK4(P, BASE, OUT) do { unsigned a0 = cvtpk(P[BASE + 0], P[BASE + 1]), a1 = cvtpk(P[BASE + 2], P[BASE + 3]);   \
    unsigned b0 = cvtpk(P[BASE + 4], P[BASE + 5]), b1 = cvtpk(P[BASE + 6], P[BASE + 7]);                              \
    auto r0 = __builtin_amdgcn_permlane32_swap(a0, b0, false, false); auto r1 = __builtin_amdgcn_permlane32_swap(a1, b1, false, false); \
    u32x4 w = {r0[0], r1[0], r0[1], r1[1]}; OUT = *reinterpret_cast<bf16x8*>(&w); } while (0)
  PK4(p0, 0, pa0); PK4(p0, 8, pa1); PK4(p1, 0, pa2); PK4(p1, 8, pa3);
#undef PK4
}
__device__ __forceinline__ void qkt(f32x16& p0, f32x16& p1, const bf16* Ks, const bf16x8* qr, int r32, int hi) {
  p0 = f32x16{}; p1 = f32x16{};
  for (int d0 = 0; d0 < 8; ++d0) { int cb = (d0 * 16 + hi * 8) * 2;
    bf16x8 b0 = *reinterpret_cast<const bf16x8*>((const char*)Ks + KSWZ(r32, cb));
    bf16x8 b1 = *reinterpret_cast<const bf16x8*>((const char*)Ks + KSWZ(32 + r32, cb));
    p0 = __builtin_amdgcn_mfma_f32_32x32x16_bf16(b0, qr[d0], p0, 0, 0, 0);
    p1 = __builtin_amdgcn_mfma_f32_32x32x16_bf16(b1, qr[d0], p1, 0, 0, 0); }
}
__device__ __forceinline__ int v_st(int k, int c) { const int kk = (k & ~0xC) | ((k & 4) << 1) | ((k & 8) >> 1); return ((kk >> 3) * 4 + (c >> 5)) * 512 + ((kk & 7) * 32 + (c & 31)) * 2; }
__device__ __forceinline__ int v_rd_base(int lane) { return ((lane & 3) << 3) | (((lane >> 2) & 3) << 6) | (((lane >> 4) & 1) << 5) | (((lane >> 5) & 1) << 8); }
constexpr int v_rd_off(int d0, int ks, int half) { return d0 * 512 + ks * 4096 + half * 2048; }
template <int OFF> __device__ __forceinline__ s16x4 tr_read(int vb) {
  s16x4 r; asm volatile("ds_read_b64_tr_b16 %0, %1 offset:%2" : "=&v"(r) : "v"(vb), "i"(OFF) : "memory"); return r;
}
template <int D0> __device__ __forceinline__ void pv_one(f32x16& od, int vb, bf16x8 pa0, bf16x8 pa1, bf16x8 pa2, bf16x8 pa3) {
  const s16x4 l0 = tr_read<v_rd_off(D0, 0, 0)>(vb), h0 = tr_read<v_rd_off(D0, 0, 1)>(vb), l1 = tr_read<v_rd_off(D0, 1, 0)>(vb), h1 = tr_read<v_rd_off(D0, 1, 1)>(vb);
  const s16x4 l2 = tr_read<v_rd_off(D0, 2, 0)>(vb), h2 = tr_read<v_rd_off(D0, 2, 1)>(vb), l3 = tr_read<v_rd_off(D0, 3, 0)>(vb), h3 = tr_read<v_rd_off(D0, 3, 1)>(vb);
  asm volatile("s_waitcnt lgkmcnt(0)" ::: "memory"); SBAR();
#define PK(L, H) (bf16x8){L[0], L[1], L[2], L[3], H[0], H[1], H[2], H[3]}
  od = __builtin_amdgcn_mfma_f32_32x32x16_bf16(pa0, PK(l0, h0), od, 0, 0, 0);
  od = __builtin_amdgcn_mfma_f32_32x32x16_bf16(pa1, PK(l1, h1), od, 0, 0, 0);
  od = __builtin_amdgcn_mfma_f32_32x32x16_bf16(pa2, PK(l2, h2), od, 0, 0, 0);
  od = __builtin_amdgcn_mfma_f32_32x32x16_bf16(pa3, PK(l3, h3), od, 0, 0, 0);
#undef PK
}
__device__ __forceinline__ void pv_d0(f32x16* o, int vb, bf16x8 pa0, bf16x8 pa1, bf16x8 pa2, bf16x8 pa3) {
  pv_one<0>(o[0], vb, pa0, pa1, pa2, pa3); pv_one<1>(o[1], vb, pa0, pa1, pa2, pa3); pv_one<2>(o[2], vb, pa0, pa1, pa2, pa3); pv_one<3>(o[3], vb, pa0, pa1, pa2, pa3);
}
template <typename TQ>
__device__ __forceinline__ void attn_dense_body(const TQ* __restrict__ Qb, const bf16* __restrict__ Kh, const bf16* __restrict__ Vh,
                                                bf16* __restrict__ Ob, int seq, char* lds, int tid) {
  using St = Stage<bf16>; using SQ = Stage<TQ>;
  const int wid = tid >> 6, lane = tid & 63, r32 = lane & 31, hi = lane >> 5;
  bf16* V_lds = (bf16*)lds; bf16* K_lds = (bf16*)(lds + 2 * SHM_V);
  float* ws = (float*)(lds + 2 * SHM_V + 2 * SHM_K) + wid * 64; float* li_l = ws; float* al_l = ws + 32;
  float m_reg = -1e30f, l_reg = 0; f32x16 o[4] = {}; bf16x8 qr[8];
  const TQ* Qw = Qb + (long)(wid * QBLK + r32) * LDQ + hi * 8;
#pragma unroll
  for (int d0 = 0; d0 < 8; ++d0) qr[d0] = SQ::tobf(SQ::ld8(Qw + d0 * 16));
  const int sr = tid >> 4, sc = (tid & 15) * 8, vst0 = v_st(sr, sc), vst1 = v_st(32 + sr, sc);
  const int vb0 = (int)(uintptr_t)V_lds + v_rd_base(lane);
  struct { typename St::T vs0, vs1, ks0, ks1; } sr_[SDEPTH];
#define SLOAD(i, k0) do { sr_[i].vs0 = St::ld8(&Vh[(long)((k0) + sr) * LDK + sc]); sr_[i].vs1 = St::ld8(&Vh[(long)((k0) + 32 + sr) * LDK + sc]); \
    sr_[i].ks0 = St::ld8(&Kh[(long)((k0) + sr) * LDK + sc]); sr_[i].ks1 = St::ld8(&Kh[(long)((k0) + 32 + sr) * LDK + sc]); } while (0)
#define SWRITE(b, i) do { *(bf16x8*)((char*)V_lds + (b) * SHM_V + vst0) = St::tobf(sr_[i].vs0);          \
    *(bf16x8*)((char*)V_lds + (b) * SHM_V + vst1) = St::tobf(sr_[i].vs1); int kc = sc * 2;               \
    *(bf16x8*)((char*)K_lds + (b) * SHM_K + KSWZ(sr, kc)) = St::tobf(sr_[i].ks0);                       \
    *(bf16x8*)((char*)K_lds + (b) * SHM_K + KSWZ(32 + sr, kc)) = St::tobf(sr_[i].ks1); } while (0)
#define SWAIT() do { if constexpr (SDEPTH == 2) asm volatile("s_waitcnt vmcnt(4)" ::: "memory"); else asm volatile("s_waitcnt vmcnt(0)" ::: "memory"); } while (0)
#define RESC(a) do { if (__any((a) < 1.f)) { if (hi == 0) al_l[r32] = (a); asm volatile("s_waitcnt lgkmcnt(0)" ::: "memory"); \
    for (int d = 0; d < 4; ++d) for (int r = 0; r < 16; ++r) o[d][r] *= al_l[crow(r, hi)]; } } while (0)
  f32x16 pA0, pA1, pB0, pB1; float mnA, mnB, alA, alB; bf16x8 pa0, pa1, pa2, pa3; const int NT = seq / KVBLK;
  constexpr int SE = 0, SO = SDEPTH - 1;
  SLOAD(SE, 0); asm volatile("s_waitcnt vmcnt(0)" ::: "memory"); SWRITE(0, SE); __syncthreads();
  qkt(pA0, pA1, K_lds, qr, r32, hi); partialSM(pA0, pA1, m_reg, mnA, alA);
  SLOAD(SO, KVBLK); SLOAD(SE, 2 * KVBLK);
  SWAIT(); SWRITE(1, SO); __syncthreads();
  for (int j = 1; j + 1 < NT; j += 2) {
    SBAR(); qkt(pB0, pB1, (bf16*)((char*)K_lds + SHM_K), qr, r32, hi);
    finishSM(pA0, pA1, alA, l_reg, pa0, pa1, pa2, pa3); SBAR();
    SLOAD(SO, (j + SDEPTH) * KVBLK); SBAR();
    pv_d0(o, vb0, pa0, pa1, pa2, pa3); partialSM(pB0, pB1, m_reg, mnB, alB);
    __syncthreads(); SWAIT(); SWRITE(0, SE);
    RESC(alB); __syncthreads();
    SBAR(); qkt(pA0, pA1, K_lds, qr, r32, hi);
    finishSM(pB0, pB1, alB, l_reg, pa0, pa1, pa2, pa3); SBAR();
    SLOAD(SE, (j + 3 < NT ? j + 3 : NT - 1) * KVBLK); SBAR();
    pv_d0(o, vb0 + (int)SHM_V, pa0, pa1, pa2, pa3); partialSM(pA0, pA1, m_reg, mnA, alA);
    __syncthreads(); SWAIT(); SWRITE(1, SO);
    RESC(alA); __syncthreads();
  }
  SBAR(); qkt(pB0, pB1, (bf16*)((char*)K_lds + SHM_K), qr, r32, hi);
  finishSM(pA0, pA1, alA, l_reg, pa0, pa1, pa2, pa3); SBAR();
  pv_d0(o, vb0, pa0, pa1, pa2, pa3); partialSM(pB0, pB1, m_reg, mnB, alB);
  __syncthreads(); RESC(alB);
  finishSM(pB0, pB1, alB, l_reg, pa0, pa1, pa2, pa3); SBAR();
  pv_d0(o, vb0 + (int)SHM_V, pa0, pa1, pa2, pa3);
  int lane_e = lane; asm volatile("" : "+v"(lane_e)); const int r32e = lane_e & 31, hie = lane_e >> 5;
  if (hie == 0) li_l[r32e] = l_reg; asm volatile("s_waitcnt lgkmcnt(0)" ::: "memory");
  float rli[16];
#pragma unroll
  for (int r = 0; r < 16; ++r) rli[r] = __builtin_amdgcn_rcpf(li_l[crow(r, hie)]);
  unsigned short* ost = (unsigned short*)(lds + SHM_ATTN) + wid * (QBLK * D);
#pragma unroll
  for (int r = 0; r < 16; ++r) { const int orow = crow(r, hie);
#pragma unroll
    for (int d0 = 0; d0 < 4; ++d0) ost[orow * D + d0 * 32 + r32e] = (unsigned short)(cvtpk(o[d0][r] * rli[r], 0.f) & 0xffffu); }
  asm volatile("s_waitcnt lgkmcnt(0)" ::: "memory");
  bf16* Ow = Ob + (long)(wid * QBLK) * LDO;
#pragma unroll
  for (int it = 0; it < 8; ++it) { const int orow = it * 4 + (lane_e >> 4), ch = lane_e & 15;
    const u32x4 v = *reinterpret_cast<const u32x4*>(ost + orow * D + ch * 8);
    *reinterpret_cast<u32x4*>(Ow + (long)orow * LDO + ch * 8) = v; }
#undef SLOAD
#undef SWRITE
#undef SWAIT
#undef RESC
}
constexpr size_t SHM_TOTAL = SHM_ATTN + (size_t)NW * QBLK * D * 2;
}
__device__ __forceinline__ void ph_attn(const Args& a, int zz, int j, unsigned char* lds_raw, int tid, int G) {
    PH_LOCALS;
    const attn_body::bf16* QB = (const attn_body::bf16*)(ws + WS_QB); attn_body::bf16* OB = (attn_body::bf16*)(ws + WS_MIX);
    const attn_body::bf16* KP = (const attn_body::bf16*)(ws + WS_KP); const attn_body::bf16* VP = (const attn_body::bf16*)(ws + WS_VP);
    const attn_body::bf16* KSj = (const attn_body::bf16*)(ws + WS_KS) + (size_t)j * 2 * 2560 * 512; const attn_body::bf16* VSj = (const attn_body::bf16*)(ws + WS_VS) + (size_t)j * 2 * 2560 * 512;
    const int bx = blockIdx.x, vcu = (G % 8 == 0) ? (bx % 8) * (G / 8) + bx / 8 : bx;
#pragma unroll 1
    for (int u = vcu; u < 512; u += G) {
        size_t qoff, koff; int seq; const attn_body::bf16* Kb; const attn_body::bf16* Vb;
        if (u < 256) { const int b = u >> 7, rem = u & 127, h = rem >> 3, qb = rem & 7; qoff = (size_t)(MP + b * 2048 + qb * 256) * D + h * 128; koff = (size_t)(b * 2560) * 512 + (h >> 2) * 128; seq = 2560; Kb = KSj; Vb = VSj; }
        else { const int pu = u - 256, b = pu >> 4, h = pu & 15; qoff = (size_t)(b * 256) * D + h * 128; koff = (size_t)(b * 256) * 512 + (h >> 2) * 128; seq = 256; Kb = KP; Vb = VP; }
        int tid_u = tid; asm volatile("" : "+v"(tid_u));
        attn_body::attn_dense_body<attn_body::bf16>(QB + qoff, Kb + koff, Vb + koff, OB + qoff, seq, (char*)lds_raw, tid_u);
    }
}

constexpr int RG_AIMG = 0, RG_BIMG = 65536, RG_STG = 98304, RG_SUM = 131072;
__device__ __forceinline__ int swz16(int row, int colB) { return row * 256 + (colB ^ ((row & 15) << 4)); }
typedef float f32x16 __attribute__((ext_vector_type(16)));
typedef float f32x2v __attribute__((ext_vector_type(2)));
__device__ __forceinline__ int crow16(int q, int hh) { return (q & 3) + 8 * (q >> 2) + 4 * hh; }

template <bool REV> __device__ __forceinline__ void rg_scan_tile(float (&a)[16], float (&u)[16], const bool hi, float& TA, float& TB) {
    float GA[4], GB[4];
#pragma unroll
    for (int g = 0; g < 4; ++g) {
        if (!REV) {
#pragma unroll
            for (int i = 1; i < 4; ++i) { u[4 * g + i] = a[4 * g + i] * u[4 * g + i - 1] + u[4 * g + i]; a[4 * g + i] = a[4 * g + i] * a[4 * g + i - 1]; }
            GA[g] = a[4 * g + 3]; GB[g] = u[4 * g + 3];
        } else {
#pragma unroll
            for (int i = 2; i >= 0; --i) { u[4 * g + i] = a[4 * g + i] * u[4 * g + i + 1] + u[4 * g + i]; a[4 * g + i] = a[4 * g + i] * a[4 * g + i + 1]; }
            GA[g] = a[4 * g]; GB[g] = u[4 * g];
        }
    }
    float EA[8], EB[8];
#pragma unroll
    for (int g = 0; g < 4; ++g) {
        const auto ra = __builtin_amdgcn_permlane32_swap(__float_as_uint(GA[g]), __float_as_uint(GA[g]), false, false);
        const auto rb = __builtin_amdgcn_permlane32_swap(__float_as_uint(GB[g]), __float_as_uint(GB[g]), false, false);
        EA[2 * g] = __uint_as_float(ra[0]); EA[2 * g + 1] = __uint_as_float(ra[1]); EB[2 * g] = __uint_as_float(rb[0]); EB[2 * g + 1] = __uint_as_float(rb[1]);
    }
    float PA = 1.f, PB = 0.f, preA[8], preB[8];
#pragma unroll
    for (int k = 0; k < 8; ++k) { const int Gi = REV ? 7 - k : k; preA[Gi] = PA; preB[Gi] = PB; PB = EA[Gi] * PB + EB[Gi]; PA = EA[Gi] * PA; }
    TA = PA; TB = PB;
#pragma unroll
    for (int g = 0; g < 4; ++g) { const float oA = hi ? preA[2 * g + 1] : preA[2 * g], oB = hi ? preB[2 * g + 1] : preB[2 * g];
#pragma unroll
        for (int i = 0; i < 4; ++i) { u[4 * g + i] = a[4 * g + i] * oB + u[4 * g + i]; a[4 * g + i] = a[4 * g + i] * oA; } }
}

__device__ __forceinline__ void rg_load_x(unsigned long long (&x)[19], const bf16* XB, int seq_row0, int t0, int T, int n, int tid) {
    const int cg = tid & 31, tg = tid >> 5, tb = t0 + 16 * tg - 1;
    const bf16* xp = XB + ((size_t)seq_row0 + tb) * 2048 + n * 128 + 4 * cg;
#pragma unroll
    for (int k = 0; k < 19; ++k) {
        if (k == 0 || k >= 17) { const int t = tb + k, tc = t < 0 ? 0 : (t >= T ? T - 1 : t); const unsigned long long v = *(const unsigned long long*)(xp + (ptrdiff_t)(tc - tb) * 2048); x[k] = (t >= 0 && t < T) ? v : 0ull; }
        else x[k] = *(const unsigned long long*)(xp + (size_t)k * 2048);
    }
}
__device__ __forceinline__ f32x4 bf4_to_f32(unsigned long long v) { const unsigned lo = (unsigned)v, hi = (unsigned)(v >> 32);
    f32x4 o; o.x = __builtin_bit_cast(float, lo << 16); o.y = __builtin_bit_cast(float, lo & 0xffff0000u); o.z = __builtin_bit_cast(float, hi << 16); o.w = __builtin_bit_cast(float, hi & 0xffff0000u); return o; }
template <bool DO_F, bool DO_B, bool LOAD_HF>
__device__ __forceinline__ void rg_step(LAS unsigned char* lds, const bf16* XB, float* HF, const bf16* GT, bf16* MIX, int seq_row0, int t0, int T, int n, int sub, int ch, int tid, int lane, int wave,
                                        f32x4 w0, f32x4 w1, f32x4 w2, f32x4 w3, f32x4 cb, float ba0, float bx0, float cf0, float ba1, float bx1, float cf1, float& Sf, float& Sb,
                                        unsigned long long (&xr)[19], int nrow0, int nt0, int nT, bool has_next, int par) {
    asm volatile("" : "+v"(tid), "+v"(lane));
    const int cg = tid & 31, tg = tid >> 5, c = lane & 31, hh = lane >> 5; const bool hi = lane >= 32;
    {
        f32x4 xa = bf4_to_f32(xr[0]), xb_ = bf4_to_f32(xr[1]), xc_ = bf4_to_f32(xr[2]);
#pragma unroll
        for (int i = 0; i < 16; ++i) {
            const f32x4 xd = bf4_to_f32(xr[i + 3]);
            const f32x4 v = cb + w0 * xa + w1 * xb_ + w2 * xc_ + w3 * xd;
            xa = xb_; xb_ = xc_; xc_ = xd;
            const int lr = 16 * tg + i;
            *(LAS unsigned long long*)(lds + RG_AIMG + swz16(lr, 8 * cg)) = pack4(v);
        }
    }
    if (has_next) rg_load_x(xr, XB, nrow0, nt0, nT, n, tid);
    const int ch0 = ch - c;
    const size_t trow0 = (size_t)seq_row0 + t0 + 32 * wave;
    LAS unsigned char* stg = lds + RG_STG + wave * 2048;
    v4u gte4[2]; float hfe[16];
    constexpr bool EARLY = DO_B && !DO_F;
    if (EARLY) {
#pragma unroll
        for (int i = 0; i < 2; ++i) gte4[i] = *(const v4u*)(GT + (trow0 + (lane >> 2) + 16 * i) * 2048 + ch0 + 8 * (lane & 3));
        if (LOAD_HF) {
#pragma unroll
            for (int q = 0; q < 16; ++q) hfe[q] = HF[(trow0 + crow16(q, hh) - MP) * 2048 + ch];
        }
    }
    f32x16 acc[4];
#pragma unroll
    for (int e = 0; e < 4; ++e)
#pragma unroll
        for (int q = 0; q < 16; ++q) acc[e][q] = 0.f;
    {
        bf16x8 A[8];
        const int row = 32 * wave + c;
#pragma unroll
        for (int s = 0; s < 8; ++s) A[s] = *(const LAS bf16x8*)(lds + RG_AIMG + swz16(row, (2 * s + hh) * 16));
#pragma unroll
        for (int e = 0; e < 4; ++e) {
            if ((e < 2 && !DO_F) || (e >= 2 && !DO_B)) continue;
            bf16x8 Bf[8];
#pragma unroll
            for (int s = 0; s < 8; ++s) Bf[s] = *(const LAS bf16x8*)(lds + RG_BIMG + e * 8192 + swz16(c, (2 * s + hh) * 16));
            asm volatile("" : "+v"(Bf[0]), "+v"(Bf[1]), "+v"(Bf[2]), "+v"(Bf[3]), "+v"(Bf[4]), "+v"(Bf[5]), "+v"(Bf[6]), "+v"(Bf[7]));
#pragma unroll
            for (int s = 0; s < 8; ++s) acc[e] = __builtin_amdgcn_mfma_f32_32x32x16_bf16(A[s], Bf[s], acc[e], 0, 0, 0);
        }
    }
    float af[16], uf[16], ab[16], ub[16];
#pragma unroll
    for (int q = 0; q < 16; ++q) {
        const float xc = bf2f(*(const LAS unsigned short*)(lds + RG_AIMG + swz16(32 * wave + crow16(q, hh), 64 * sub + 2 * c)));
        if (DO_F) rg_elem(acc[0][q] + ba0, acc[1][q] + bx0, cf0, xc, af[q], uf[q]);
        if (DO_B) rg_elem(acc[2][q] + ba1, acc[3][q] + bx1, cf1, xc, ab[q], ub[q]);
    }
    float TAf = 1.f, TBf = 0.f, TAb = 1.f, TBb = 0.f;
    if (DO_F) rg_scan_tile<false>(af, uf, hi, TAf, TBf);
    if (DO_B) rg_scan_tile<true>(ab, ub, hi, TAb, TBb);
    LAS f32x2v* SUM = (LAS f32x2v*)(lds + RG_SUM + par * 4096);
    if (hh == 0) { if (DO_F) SUM[(0 * 8 + wave) * 32 + c] = (f32x2v){TAf, TBf}; if (DO_B) SUM[(1 * 8 + wave) * 32 + c] = (f32x2v){TAb, TBb}; }
    __syncthreads();
    float Cf = 0.f, Cb = 0.f;
    if (DO_F) { float S = Sf;
#pragma unroll
        for (int w = 0; w < 8; ++w) { const f32x2v v = SUM[(0 * 8 + w) * 32 + c]; if (w == wave) Cf = S; S = v.x * S + v.y; }
        Sf = S; }
    if (DO_B) { float S = Sb;
#pragma unroll
        for (int w = 7; w >= 0; --w) { const f32x2v v = SUM[(1 * 8 + w) * 32 + c]; if (w == wave) Cb = S; S = v.x * S + v.y; }
        Sb = S; }
    if (DO_F && !DO_B) {
#pragma unroll
        for (int q = 0; q < 16; ++q) HF[(trow0 + crow16(q, hh) - MP) * 2048 + ch] = uf[q] + af[q] * Cf;
    } else {
        if (!EARLY) {
#pragma unroll
            for (int i = 0; i < 2; ++i) gte4[i] = *(const v4u*)(GT + (trow0 + (lane >> 2) + 16 * i) * 2048 + ch0 + 8 * (lane & 3));
        }
#pragma unroll
        for (int i = 0; i < 2; ++i) *(LAS v4u*)(stg + ((lane >> 2) + 16 * i) * 64 + 16 * (lane & 3)) = gte4[i];
        float yg[16];
#pragma unroll
        for (int q = 0; q < 16; ++q) {
            const float hfv = LOAD_HF ? hfe[q] : (uf[q] + af[q] * Cf);
            const float y = hfv + (ub[q] + ab[q] * Cb);
            yg[q] = y * bf2f(*(const LAS unsigned short*)(stg + crow16(q, hh) * 64 + 2 * c));
        }
#pragma unroll
        for (int q = 0; q < 16; ++q) *(LAS unsigned short*)(stg + crow16(q, hh) * 64 + 2 * c) = (unsigned short)(pg8::cvt_pk_bf16(yg[q], 0.f) & 0xffffu);
#pragma unroll
        for (int i = 0; i < 2; ++i) { const v4u v = *(const LAS v4u*)(stg + ((lane >> 2) + 16 * i) * 64 + 16 * (lane & 3));
            *(v4u*)(MIX + (trow0 + (lane >> 2) + 16 * i) * 2048 + ch0 + 8 * (lane & 3)) = v; }
    }
}

__device__ __forceinline__ void ph_rg_fused(const Args& a, int zz, int jl, LAS unsigned char* lds, int tid, int lane, int wave, int G) {
    PH_LOCALS;
    const bf16* XB = (const bf16*)(ws + WS_XB); float* HF = (float*)(ws + WS_HF);
    const bf16* GT = (const bf16*)(ws + WS_GATE); bf16* MIX = (bf16*)(ws + WS_MIX);
    const int bx = blockIdx.x, vcu = (G % 8 == 0) ? (bx % 8) * (G / 8) + bx / 8 : bx;
    const int c = lane & 31, hh = lane >> 5, cg = tid & 31;
#pragma unroll 1
    for (int u = vcu; u < 256; u += G) {
        int n, sub, b0; const bool samp = u < 128;
        if (samp) { b0 = u >> 6; n = (u & 63) >> 2; sub = u & 3; } else { const int pu = u - 128; n = pu >> 3; sub = (pu >> 1) & 3; b0 = (pu & 1) * 8; }
        const int ch = n * 128 + sub * 32 + c;
        const float ba0 = a.in[zz + I_BRGA][(jl * 2 + 0) * 2048 + ch], ba1 = a.in[zz + I_BRGA][(jl * 2 + 1) * 2048 + ch];
        const float bx0 = a.in[zz + I_BRGX][(jl * 2 + 0) * 2048 + ch], bx1 = a.in[zz + I_BRGX][(jl * 2 + 1) * 2048 + ch];
        const float cf0 = rg_coef(a.in[zz + I_LAM][(jl * 2 + 0) * 2048 + ch]), cf1 = rg_coef(a.in[zz + I_LAM][(jl * 2 + 1) * 2048 + ch]);
        const float* cwp = a.in[zz + I_CONVW] + (size_t)jl * 4 * 2048 + n * 128 + 4 * cg;
        const f32x4 w0 = *(const f32x4*)cwp, w1 = *(const f32x4*)(cwp + 2048), w2 = *(const f32x4*)(cwp + 4096), w3 = *(const f32x4*)(cwp + 6144);
        const f32x4 cb = *(const f32x4*)(a.in[zz + I_CONVB] + (size_t)jl * 2048 + n * 128 + 4 * cg);
        __syncthreads();
        {
            const int kl = tid & 31, jg = tid >> 5;
#pragma unroll
            for (int e = 0; e < 4; ++e) {
                const float* src = ((e & 1) ? a.in[zz + I_WRGX] : a.in[zz + I_WRGA]) + ((size_t)((jl * 2 + (e >> 1)) * 16 + n) * 128 + 8 * jg) * 128 + sub * 32 + kl;
                f32x4 f0, f1; f0.x = src[0]; f0.y = src[128]; f0.z = src[256]; f0.w = src[384]; f1.x = src[512]; f1.y = src[640]; f1.z = src[768]; f1.w = src[896];
                *(LAS v4u*)(lds + RG_BIMG + e * 8192 + swz16(kl, 16 * jg)) = pack8(f0, f1);
            }
        }
        __syncthreads();
        unsigned long long xr[19]; int stepc = 0;
        if (samp) {
            const int srow0 = MP + b0 * 2048;
            float Sf = a.in[zz + I_STATE][((size_t)(b0 * 2 + jl) * 2 + 0) * 2048 + ch], Sb = a.in[zz + I_STATE][((size_t)(b0 * 2 + jl) * 2 + 1) * 2048 + ch];
            rg_load_x(xr, XB, srow0, 0, 2048, n, tid);
#pragma unroll 1
            for (int ss = 0; ss < 8; ++ss) rg_step<true, false, false>(lds, XB, HF, GT, MIX, srow0, 256 * ss, 2048, n, sub, ch, tid, lane, wave, w0, w1, w2, w3, cb, ba0, bx0, cf0, ba1, bx1, cf1, Sf, Sb,
                                                                      xr, srow0, ss < 7 ? 256 * (ss + 1) : 256 * 7, 2048, true, (stepc++) & 1);
#pragma unroll 1
            for (int ss = 7; ss >= 0; --ss) rg_step<false, true, true>(lds, XB, HF, GT, MIX, srow0, 256 * ss, 2048, n, sub, ch, tid, lane, wave, w0, w1, w2, w3, cb, ba0, bx0, cf0, ba1, bx1, cf1, Sf, Sb,
                                                                       xr, srow0, ss > 0 ? 256 * (ss - 1) : 0, 2048, ss > 0, (stepc++) & 1);
        } else {
            rg_load_x(xr, XB, b0 * 256, 0, 256, n, tid);
#pragma unroll 1
            for (int bb = 0; bb < 8; ++bb) {
                const int b = b0 + bb; float Sf = 0.f, Sb = 0.f;
                rg_step<true, true, false>(lds, XB, HF, GT, MIX, b * 256, 0, 256, n, sub, ch, tid, lane, wave, w0, w1, w2, w3, cb, ba0, bx0, cf0, ba1, bx1, cf1, Sf, Sb, xr, (bb < 7 ? b + 1 : b) * 256, 0, 256, bb < 7, (stepc++) & 1);
                if (wave == 0 && hh == 0) { out[OUT_ST + ((size_t)(b * 2 + jl) * 2 + 0) * 2048 + ch] = Sf; out[OUT_ST + ((size_t)(b * 2 + jl) * 2 + 1) * 2048 + ch] = Sb; }
            }
        }
    }
}

#define RUN(p) (lo <= (p) && (p) < hi)
#define PH_BEGIN int zz = 0; asm volatile("" : "+s"(zz)); int lane_ = (int)__builtin_amdgcn_mbcnt_hi(~0u, __builtin_amdgcn_mbcnt_lo(~0u, 0u)); asm volatile("" : "+v"(lane_)); const int lane = lane_, wave = wave_k, tid = wave_k * 64 + lane_; \
    unsigned char* const ws = args.ws + zz; const int G = (int)gridDim.x + zz; (void)lane; (void)wave; (void)ws; (void)G
#define SEAM(p) do { if ((p) + 1 < hi) { XcdBarrier b2; b2.bar = (unsigned*)(args.ws + zz) + 4096; b2.x = xb_xcc_id(); b2.st = (volatile LAS unsigned*)(lds + LDSCTL_OFF); for (int repb_ = 0; repb_ < MK_REP_BAR; ++repb_) xcd_barrier(b2); } } while (0)
template <int l> __device__ __forceinline__ void run_layer(const Args& args, LAS unsigned char* lds, unsigned char* lds_raw, const int lo, const int hi, const int wave_k) {
    constexpr int pb = 3 + 10 * l, j = l >> 1;
        if constexpr ((l & 1) == 0) {
            if (RUN(pb + 0)) { PH_BEGIN;
                pg8::Gemm g{(const pg8::bf16_t*)(ws + WS_XN), (const pg8::bf16_t*)(ws + WS_WRGINT) + (size_t)j * RGW * D, M, RGW, D}; pg8::StaticOrder S; S.init(M, RGW, G, (int)blockIdx.x);
                pg8::EpiRgIn E{(pg8::bf16_t*)(ws + WS_GATE), (pg8::bf16_t*)(ws + WS_XB)};
                for (int rep_ = 0; rep_ < MK_REP_GEMM; ++rep_) pg8::gemm_phase<pg8::EpiRgIn, pg8::StaticOrder, MK_ALIGN, MK_SP2>(lds, g, S, E, wave);
                SEAM(pb + 0);
            }
#if MK_NAIVE_RG
            if (RUN(pb + 1)) { PH_BEGIN; ph_rg_conv_naive(args, zz, j, tid, G); SEAM(pb + 1); }
            if (RUN(pb + 2)) { PH_BEGIN; ph_rg_gates_naive(args, zz, j, tid, G); SEAM(pb + 2); }
            if (RUN(pb + 3)) { PH_BEGIN; ph_rg_scan_naive(args, zz, j, tid, G); SEAM(pb + 3); }
            if (RUN(pb + 4)) { PH_BEGIN; ph_rg_y_naive(args, zz, tid, G); SEAM(pb + 4); }
#else
            if (RUN(pb + 2)) { PH_BEGIN; for (int rep_ = 0; rep_ < MK_REP_RG; ++rep_) ph_rg_fused(args, zz, j, lds, tid, lane, wave, G); SEAM(pb + 2); }
#endif
        } else {
            if (RUN(pb + 0)) { PH_BEGIN;
                pg8::Gemm g{(const pg8::bf16_t*)(ws + WS_XN), (const pg8::bf16_t*)(ws + WS_WQKVT) + (size_t)j * NQKV * D, M, NQKV, D}; pg8::StaticOrder S; S.init(M, NQKV, G, (int)blockIdx.x);
                pg8::EpiBf16T<false> E{(pg8::bf16_t*)(ws + WS_QKV), NQKV};
                for (int rep_ = 0; rep_ < MK_REP_GEMM; ++rep_) pg8::gemm_phase<pg8::EpiBf16T<false>, pg8::StaticOrder, MK_ALIGN, MK_SP2>(lds, g, S, E, wave);
                SEAM(pb + 0);
            }
            if (RUN(pb + 1)) { PH_BEGIN; for (int rep_ = 0; rep_ < MK_REP_QK; ++rep_) ph_qknorm(args, zz, j, lane, wave, G); SEAM(pb + 1); }
            if (RUN(pb + 2)) { PH_BEGIN;
#if MK_NAIVE_ATTN
                ph_attn_naive(args, zz, j, tid, G);
#else
                for (int rep_ = 0; rep_ < MK_REP_ATT; ++rep_) ph_attn(args, zz, j, lds_raw, tid, G);
#endif
                SEAM(pb + 2);
            }
        }
        if (RUN(pb + 5)) { PH_BEGIN;
            const pg8::bf16_t* Wt = (l & 1) ? (const pg8::bf16_t*)(ws + WS_WOT) + (size_t)j * D * D : (const pg8::bf16_t*)(ws + WS_WRGOUTT) + (size_t)j * D * D;
            pg8::Gemm g{(const pg8::bf16_t*)(ws + WS_MIX), Wt, M, D, D}; pg8::StaticOrder S; S.init(M, D, G, (int)blockIdx.x);
            pg8::EpiBf16T<false> E{(pg8::bf16_t*)(ws + WS_BR), D};
            for (int rep_ = 0; rep_ < MK_REP_GEMM; ++rep_) pg8::gemm_phase<pg8::EpiBf16T<false>, pg8::StaticOrder, MK_ALIGN, MK_SP2>(lds, g, S, E, wave);
            SEAM(pb + 5);
        }
        if (RUN(pb + 6)) { PH_BEGIN; for (int rep_ = 1; rep_ < MK_REP_POST; ++rep_) ph_post(args, zz, l, 0, lane, wave, G, true); ph_post(args, zz, l, 0, lane, wave, G); SEAM(pb + 6); }
        if (RUN(pb + 7)) { PH_BEGIN;
            pg8::Gemm g{(const pg8::bf16_t*)(ws + WS_XN), (const pg8::bf16_t*)(ws + WS_W1T) + (size_t)l * FF * D, M, FF, D}; pg8::StaticOrder S; S.init(M, FF, G, (int)blockIdx.x);
            pg8::EpiBf16T<true> E{(pg8::bf16_t*)(ws + WS_H), FF};
            for (int rep_ = 0; rep_ < MK_REP_FF1; ++rep_) pg8::gemm_phase<pg8::EpiBf16T<true>, pg8::StaticOrder, MK_ALIGN, MK_SP2>(lds, g, S, E, wave);
            SEAM(pb + 7);
        }
        if (RUN(pb + 8)) { PH_BEGIN;
            pg8::Gemm g{(const pg8::bf16_t*)(ws + WS_H), (const pg8::bf16_t*)(ws + WS_W2T) + (size_t)l * D * FF, M, D, FF}; pg8::StaticOrder S; S.init(M, D, G, (int)blockIdx.x);
            pg8::EpiBf16T<false> E{(pg8::bf16_t*)(ws + WS_BR), D};
            for (int rep_ = 0; rep_ < MK_REP_FF2; ++rep_) pg8::gemm_phase<pg8::EpiBf16T<false>, pg8::StaticOrder, MK_ALIGN, MK_SP2>(lds, g, S, E, wave);
            SEAM(pb + 8);
        }
        if (RUN(pb + 9)) { PH_BEGIN; for (int rep_ = 1; rep_ < MK_REP_POST; ++rep_) ph_post(args, zz, l, 1, lane, wave, G, true); ph_post(args, zz, l, 1, lane, wave, G); SEAM(pb + 9); }
}

__global__ void __launch_bounds__(NTHR, 2) mk_fwd(Args args) {
    extern __shared__ __attribute__((aligned(16))) unsigned char lds_raw[];
    LAS unsigned char* lds = (LAS unsigned char*)lds_raw;
    if (threadIdx.x < 128) ((LAS unsigned*)(lds + LDSCTL_OFF))[threadIdx.x] = 0u;
    __syncthreads();
    (void)xcd_barrier_post((unsigned*)(args.ws + WS_CTL) + 4096, (volatile LAS unsigned*)(lds + LDSCTL_OFF));
    const int lo = args.ph_lo, hi = args.ph_hi;
    const int wave_k = __builtin_amdgcn_readfirstlane(threadIdx.x >> 6);
    if (RUN(0)) { PH_BEGIN; for (int rep_ = 0; rep_ < MK_REP_PRO; ++rep_) ph_prologue(args, zz, lds, tid, lane, wave, G); SEAM(0); }
    if (RUN(1)) { PH_BEGIN; ph_modreduce(args, zz, tid, G); SEAM(1); }
    if (RUN(2)) { PH_BEGIN; ph_pre0(args, zz, lane, wave, G); SEAM(2); }

    run_layer<0>(args, lds, lds_raw, lo, hi, wave_k); run_layer<1>(args, lds, lds_raw, lo, hi, wave_k); run_layer<2>(args, lds, lds_raw, lo, hi, wave_k); run_layer<3>(args, lds, lds_raw, lo, hi, wave_k);
#undef RUN
#undef SEAM
#undef PH_BEGIN
}

extern "C" void kernel_launch(void* const* d_in, const int* in_sizes, int n_in, void* d_out, int out_size, void* d_ws, size_t ws_size, hipStream_t stream) {
    static int grid = 0;
    if (grid == 0) {
        if (n_in != N_IN || out_size != OUT_TOTAL || ws_size < WS_END) { fprintf(stderr, "kernel_launch: built for %d inputs, %d outputs, >= %zu bytes of workspace; got %d, %d, %zu; nothing launched\n", (int)N_IN, OUT_TOTAL, (size_t)WS_END, n_in, out_size, ws_size); grid = -1; return; }
        int dev = 0, cus = 0, per_cu = 0;
        if (hipGetDevice(&dev) != hipSuccess || hipDeviceGetAttribute(&cus, hipDeviceAttributeMultiprocessorCount, dev) != hipSuccess) { fprintf(stderr, "kernel_launch: device query failed\n"); grid = -1; return; }
        if (hipFuncSetAttribute((const void*)mk_fwd, hipFuncAttributeMaxDynamicSharedMemorySize, LDS_BYTES) != hipSuccess) { fprintf(stderr, "kernel_launch: hipFuncSetAttribute failed\n"); grid = -1; return; }
        if (hipOccupancyMaxActiveBlocksPerMultiprocessor(&per_cu, (const void*)mk_fwd, NTHR, LDS_BYTES) != hipSuccess || per_cu < 1) fprintf(stderr, "kernel_launch: note: occupancy query reports %d workgroups per CU\n", per_cu);
        (void)hipGetLastError();
        grid = cus;
    }
    if (grid < 0) return;
    if (hipMemsetAsync((char*)d_ws + WS_CTL, 0, CTL_ZERO_BYTES, stream) != hipSuccess) { fprintf(stderr, "kernel_launch: memset failed\n"); return; }
    Args a{};
    for (int i = 0; i < N_IN; ++i) a.in[i] = (const float*)d_in[i];
    a.out = (float*)d_out; a.ws = (unsigned char*)d_ws;
#if MK_ONE_LAUNCH
    a.ph_lo = 0; a.ph_hi = NPH;
    hipLaunchKernelGGL(mk_fwd, dim3(grid), dim3(NTHR), LDS_BYTES, stream, a);
#else
    for (int p = 0; p < NPH; ++p) {
        if (!phase_active(p)) continue;
        a.ph_lo = p; a.ph_hi = p + 1;
        hipLaunchKernelGGL(mk_fwd, dim3(grid), dim3(NTHR), LDS_BYTES, stream, a);
    }
#endif
    const hipError_t le = hipPeekAtLastError();
    if (le != hipSuccess) fprintf(stderr, "kernel_launch: launch failed: %s\n", hipGetErrorName(le));
}
```
